# Optimizing an MI355X kernel written in HIP

```python
import jax, jax.numpy as jnp
from jax import lax
import numpy as np

D_MODEL = 1024
BATCH = 8
SEQ = 2048
DEPTH = 2
DEC_BATCH = 128
DEC_SEQ = 8
PAST_LEN = 16384
PAGE_SIZE = 128

N_META = 16
N_MIXERS = 2
N_CONV_LAYERS = (DEPTH + 1) // N_MIXERS
N_SSM_LAYERS = DEPTH // N_MIXERS
SC_WIDTH = 3
D_INNER = 2 * D_MODEL
SSM_HEAD_DIM = 64
SSM_HEADS = D_INNER // SSM_HEAD_DIM
SSM_GROUPS = 4
HEADS_PER_GROUP = SSM_HEADS // SSM_GROUPS
D_STATE = 128
SSM_CONV_WIDTH = 4
CONV_DIM = D_INNER + 2 * SSM_GROUPS * D_STATE
SSM_IN_DIM = D_INNER + CONV_DIM + SSM_HEADS
SSM_CHUNK = 128
D_FF = 2816
FFN_CONV_WIDTH = 3
EPS = 1e-5

kernel_name = "hybrid_shortconv_ssd_convffn_step"


def rmsnorm(x, w):
    xf = x.astype(jnp.float32)
    r = lax.rsqrt(jnp.mean(xf * xf, axis=-1, keepdims=True) + EPS)
    return (xf * r).astype(x.dtype) * w


def causal_dwconv(x, prefix, w):
    width = w.shape[0]
    L = x.shape[1]
    xp = jnp.concatenate([prefix.astype(x.dtype), x], axis=1)
    y = xp[:, 0:L] * w[0]
    for k in range(1, width):
        y = y + xp[:, k:k + L] * w[k]
    return y, xp[:, L:]


def short_conv_mixer(h, prefix, w_in, conv_w, w_out):
    b_gate, c_gate, xv = jnp.split(h @ w_in, 3, axis=-1)
    v, new_prefix = causal_dwconv(c_gate * xv, prefix, conv_w)
    return (b_gate * v) @ w_out, new_prefix


def ssd_scan(x, dt, a, bm, cm, s0, chunk):
    b_, L = x.shape[0], x.shape[1]
    nc = L // chunk
    rs = lambda t: t.reshape((b_, nc, chunk) + t.shape[2:])
    x, dt, bm, cm = rs(x), rs(dt), rs(bm), rs(cm)
    cum = jnp.cumsum(dt * a, axis=2)
    seg = cum[:, :, :, None] - cum[:, :, None, :]
    causal = jnp.tril(jnp.ones((chunk, chunk), dtype=bool))[None, None, :, :, None, None]
    decay = jnp.exp(jnp.where(causal, seg, -jnp.inf))
    cb = jnp.einsum('bclgn,bcsgn->bclsg', cm, bm)
    y_diag = jnp.einsum('bclsgr,bcsgrp->bclgrp', cb[..., None] * decay * dt[:, :, None], x)
    decay_end = jnp.exp(cum[:, :, -1:] - cum)
    chunk_states = jnp.einsum('bcsgn,bcsgr,bcsgrp->bcgrpn', bm, decay_end * dt, x)
    chunk_decay = jnp.exp(cum[:, :, -1])

    def step(s, inp):
        st, dc = inp
        return s * dc[..., None, None] + st, s

    s_final, s_start = lax.scan(step, s0, (jnp.moveaxis(chunk_states, 1, 0), jnp.moveaxis(chunk_decay, 1, 0)))
    s_start = jnp.moveaxis(s_start, 0, 1)
    y_off = jnp.einsum('bclgn,bcgrpn,bclgr->bclgrp', cm, s_start, jnp.exp(cum))
    y = (y_diag + y_off).reshape((b_, L) + y_diag.shape[3:])
    return y, s_final


def mamba2_mixer(h, conv_prefix, ssm_state, w_in, conv_w, conv_b, dt_bias, a_log, d_skip, norm_w, w_out, chunk, n_pad):
    b_, L, _ = h.shape
    f32 = jnp.float32
    zxbcdt = h @ w_in
    z = zxbcdt[..., :D_INNER]
    xbc = zxbcdt[..., D_INNER:D_INNER + CONV_DIM]
    dt_raw = zxbcdt[..., D_INNER + CONV_DIM:]
    xbc, new_conv = causal_dwconv(xbc, conv_prefix, conv_w)
    xbc = jax.nn.silu(xbc + conv_b)
    xs = xbc[..., :D_INNER].reshape(b_, L, SSM_GROUPS, HEADS_PER_GROUP, SSM_HEAD_DIM).astype(f32)
    bm = xbc[..., D_INNER:D_INNER + SSM_GROUPS * D_STATE].reshape(b_, L, SSM_GROUPS, D_STATE).astype(f32)
    cm = xbc[..., D_INNER + SSM_GROUPS * D_STATE:].reshape(b_, L, SSM_GROUPS, D_STATE).astype(f32)
    dt = jax.nn.softplus(dt_raw.astype(f32) + dt_bias.astype(f32)).reshape(b_, L, SSM_GROUPS, HEADS_PER_GROUP)
    a = (-jnp.exp(a_log.astype(f32))).reshape(SSM_GROUPS, HEADS_PER_GROUP)
    pad = lambda t: jnp.pad(t, [(0, 0), (n_pad, 0)] + [(0, 0)] * (t.ndim - 2))
    s0 = ssm_state.astype(f32).reshape(b_, SSM_GROUPS, HEADS_PER_GROUP, SSM_HEAD_DIM, D_STATE)
    y, s_new = ssd_scan(pad(xs), pad(dt), a, pad(bm), pad(cm), s0, chunk)
    y = y[:, n_pad:] + d_skip.astype(f32).reshape(SSM_GROUPS, HEADS_PER_GROUP)[..., None] * xs
    y = y.reshape(b_, L, D_INNER) * jax.nn.silu(z.astype(f32))
    yg = y.reshape(b_, L, SSM_GROUPS, D_INNER // SSM_GROUPS)
    yg = yg * lax.rsqrt(jnp.mean(yg * yg, axis=-1, keepdims=True) + EPS)
    y = (yg.reshape(b_, L, D_INNER) * norm_w.astype(f32)).astype(h.dtype)
    s_new = s_new.reshape(b_, SSM_HEADS, SSM_HEAD_DIM, D_STATE).astype(ssm_state.dtype)
    return y @ w_out, new_conv, s_new


def conv_ffn(h, prefix, w_up, w_gate, conv_w, w_down):
    u, new_prefix = causal_dwconv(h @ w_up, prefix, conv_w)
    return (jax.nn.silu(u) * (h @ w_gate)) @ w_down, new_prefix


def run_trunk(x, sc_prev, ssm_conv_prev, ssm_prev, ffn_prev, chunk, n_pad,
              norm_mix, norm_ffn, norm_final, sc_w_in, sc_conv_w, sc_w_out,
              ssm_w_in, ssm_conv_w, ssm_conv_b, ssm_dt_bias, ssm_a_log, ssm_d, ssm_norm_w, ssm_w_out,
              ffn_w_up, ffn_w_gate, ffn_conv_w, ffn_w_down):
    sc_new, ssm_conv_new, ssm_new, ffn_new = [], [], [], []
    for i in range(DEPTH):
        j = i // N_MIXERS
        h = rmsnorm(x, norm_mix[i])
        if i % N_MIXERS == 0:
            m, st = short_conv_mixer(h, sc_prev[j], sc_w_in[j], sc_conv_w[j], sc_w_out[j])
            sc_new.append(st)
        else:
            m, cst, sst = mamba2_mixer(h, ssm_conv_prev[j], ssm_prev[j], ssm_w_in[j], ssm_conv_w[j], ssm_conv_b[j],
                                       ssm_dt_bias[j], ssm_a_log[j], ssm_d[j], ssm_norm_w[j], ssm_w_out[j], chunk, n_pad)
            ssm_conv_new.append(cst)
            ssm_new.append(sst)
        x = x + m
        f, fst = conv_ffn(rmsnorm(x, norm_ffn[i]), ffn_prev[i], ffn_w_up[i], ffn_w_gate[i], ffn_conv_w[i], ffn_w_down[i])
        ffn_new.append(fst)
        x = x + f
    return rmsnorm(x, norm_final), jnp.stack(sc_new), jnp.stack(ssm_conv_new), jnp.stack(ssm_new), jnp.stack(ffn_new)


def setup_inputs(seed: int = 0) -> dict:
    key = jax.random.key(seed)
    ks = jax.random.split(key, 32)
    f32 = jnp.float32
    nrm = lambda k, shape, s: jax.random.normal(k, shape, f32) * s
    dt0 = jnp.exp(jax.random.uniform(ks[20], (N_SSM_LAYERS, SSM_HEADS), f32, np.log(1e-3), np.log(1e-1)))
    return {
        "x_prompt": nrm(ks[0], (BATCH, SEQ, D_MODEL), 1.0),
        "x_sample": nrm(ks[1], (DEC_BATCH, DEC_SEQ, D_MODEL), 1.0),
        "cache_sc": nrm(ks[2], (N_CONV_LAYERS, DEC_BATCH, SC_WIDTH - 1, D_MODEL), 1.0),
        "cache_ssm_conv": nrm(ks[3], (N_SSM_LAYERS, DEC_BATCH, SSM_CONV_WIDTH - 1, CONV_DIM), 1.0),
        "state_ssm": nrm(ks[4], (N_SSM_LAYERS, DEC_BATCH, SSM_HEADS, SSM_HEAD_DIM, D_STATE), 0.1),
        "cache_ffn_conv": nrm(ks[5], (DEPTH, DEC_BATCH, FFN_CONV_WIDTH - 1, D_FF), 1.0),
        "meta_tokens": nrm(ks[6], (N_META, D_MODEL), 1.0),
        "norm_mix": 1.0 + nrm(ks[7], (DEPTH, D_MODEL), 0.02),
        "norm_ffn": 1.0 + nrm(ks[8], (DEPTH, D_MODEL), 0.02),
        "norm_final": 1.0 + nrm(ks[9], (D_MODEL,), 0.02),
        "sc_w_in": nrm(ks[10], (N_CONV_LAYERS, D_MODEL, 3 * D_MODEL), D_MODEL ** -0.5),
        "sc_conv_w": nrm(ks[11], (N_CONV_LAYERS, SC_WIDTH, D_MODEL), SC_WIDTH ** -0.5),
        "sc_w_out": nrm(ks[12], (N_CONV_LAYERS, D_MODEL, D_MODEL), D_MODEL ** -0.5),
        "ssm_w_in": nrm(ks[13], (N_SSM_LAYERS, D_MODEL, SSM_IN_DIM), D_MODEL ** -0.5),
        "ssm_conv_w": nrm(ks[14], (N_SSM_LAYERS, SSM_CONV_WIDTH, CONV_DIM), SSM_CONV_WIDTH ** -0.5),
        "ssm_conv_b": nrm(ks[15], (N_SSM_LAYERS, CONV_DIM), 0.02),
        "ssm_dt_bias": dt0 + jnp.log(-jnp.expm1(-dt0)),
        "ssm_a_log": jnp.log(jax.random.uniform(ks[16], (N_SSM_LAYERS, SSM_HEADS), f32, 1.0, 16.0)),
        "ssm_d": 1.0 + nrm(ks[17], (N_SSM_LAYERS, SSM_HEADS), 0.02),
        "ssm_norm_w": 1.0 + nrm(ks[18], (N_SSM_LAYERS, D_INNER), 0.02),
        "ssm_w_out": nrm(ks[19], (N_SSM_LAYERS, D_INNER, D_MODEL), D_INNER ** -0.5),
        "ffn_w_up": nrm(ks[21], (DEPTH, D_MODEL, D_FF), D_MODEL ** -0.5),
        "ffn_w_gate": nrm(ks[22], (DEPTH, D_MODEL, D_FF), D_MODEL ** -0.5),
        "ffn_conv_w": nrm(ks[23], (DEPTH, FFN_CONV_WIDTH, D_FF), FFN_CONV_WIDTH ** -0.5),
        "ffn_w_down": nrm(ks[24], (DEPTH, D_FF, D_MODEL), D_FF ** -0.5),
    }


def reference(x_prompt, x_sample, cache_sc, cache_ssm_conv, state_ssm, cache_ffn_conv,
              meta_tokens, norm_mix, norm_ffn, norm_final, sc_w_in, sc_conv_w, sc_w_out,
              ssm_w_in, ssm_conv_w, ssm_conv_b, ssm_dt_bias, ssm_a_log, ssm_d, ssm_norm_w, ssm_w_out,
              ffn_w_up, ffn_w_gate, ffn_conv_w, ffn_w_down):
    weights = (norm_mix, norm_ffn, norm_final, sc_w_in, sc_conv_w, sc_w_out,
               ssm_w_in, ssm_conv_w, ssm_conv_b, ssm_dt_bias, ssm_a_log, ssm_d, ssm_norm_w, ssm_w_out,
               ffn_w_up, ffn_w_gate, ffn_conv_w, ffn_w_down)
    dt_ = x_prompt.dtype
    b = x_prompt.shape[0]
    xp = jnp.concatenate([jnp.broadcast_to(meta_tokens.astype(dt_)[None], (b, N_META, D_MODEL)), x_prompt], axis=1)
    n_pad = (-N_META) % SSM_CHUNK
    yp, p_sc, p_ssm_conv, p_ssm, p_ffn = run_trunk(
        xp,
        jnp.zeros((N_CONV_LAYERS, b, SC_WIDTH - 1, D_MODEL), dt_),
        jnp.zeros((N_SSM_LAYERS, b, SSM_CONV_WIDTH - 1, CONV_DIM), dt_),
        jnp.zeros((N_SSM_LAYERS, b, SSM_HEADS, SSM_HEAD_DIM, D_STATE), state_ssm.dtype),
        jnp.zeros((DEPTH, b, FFN_CONV_WIDTH - 1, D_FF), dt_),
        SSM_CHUNK, n_pad, *weights)
    y_prompt = yp[:, N_META:]
    y_sample, s_sc, s_ssm_conv, s_ssm, s_ffn = run_trunk(
        x_sample, cache_sc, cache_ssm_conv, state_ssm, cache_ffn_conv,
        x_sample.shape[1], 0, *weights)
    return (y_prompt, y_sample, p_sc, p_ssm_conv, p_ssm, p_ffn, s_sc, s_ssm_conv, s_ssm, s_ffn)
```

```cpp
#include <hip/hip_runtime.h>
#include <hip/hip_cooperative_groups.h>
#include <cstdio>
namespace cg = cooperative_groups;
namespace pg8 {
#define PG8_LAS __attribute__((address_space(3)))
typedef unsigned short bf16_t;
typedef short bf16x8 __attribute__((ext_vector_type(8)));
typedef float f32x4 __attribute__((ext_vector_type(4)));
typedef unsigned u32x4 __attribute__((ext_vector_type(4)));
constexpr int BM = 256, BK = 64, HALF = 128, HTB = HALF * BK * 2  , STAGE_BYTES = 8 * HTB, NXCD = 8, WGM = 8;

__host__ __device__ __forceinline__ int lds_byte(int r, int c) { const int st = (r >> 4) * 2 + (c >> 5), rr = r & 15, cc = c & 31, ob = rr * 64 + cc * 2; return st * 1024 + (ob ^ (((ob >> 9) & 1) << 5)); }
__host__ __device__ __forceinline__ void stage_rc(int b, int& R, int& C) { const int st = b / 1024, sb = b % 1024, swz = sb ^ (((sb >> 9) & 1) << 5); R = (st >> 1) * 16 + swz / 64; C = (st & 1) * 32 + (swz % 64) / 2; }
__host__ __device__ __forceinline__ int perm32(int rho) { const int n = rho >> 4, i = rho & 15; return 8 * (i >> 2) + 4 * n + (i & 3); }

struct Unit { int pm, pn; };
struct Gemm { const bf16_t* A; const bf16_t* Bt; int M, N, K; };

struct StaticOrder {
    int nM, nN, nwg, G, c;
    __host__ __device__ void init(int M, int N, int G_, int c_) { nM = M / BM; nN = N / BM; nwg = nM * nN; G = G_; c = c_; }
    __host__ __device__ bool next(int i, Unit& u) const {
        const long L = (long)i * G + c; if (L >= nwg) return false;
        int wgid = (int)L; { const int q = nwg / NXCD, r = nwg % NXCD, xcd = wgid % NXCD, off = wgid / NXCD; wgid = (xcd < r ? xcd * (q + 1) : r * (q + 1) + (xcd - r) * q) + off; }
        const int nig = WGM * nN, gid = wgid / nig, fm = gid * WGM, gsz = (nM - fm) < WGM ? (nM - fm) : WGM;
        u.pm = fm + ((wgid % nig) % gsz); u.pn = (wgid % nig) / gsz; return true;
    }
    __device__ __forceinline__ void a_ready(const Unit&) const {}
    __device__ __forceinline__ void done(const Unit&) const {}
};
__device__ __forceinline__ unsigned cvt_pk_bf16(float lo, float hi) { unsigned r; asm volatile("v_cvt_pk_bf16_f32 %0, %1, %2" : "=v"(r) : "v"(lo), "v"(hi)); return r; }
typedef float f32x2 __attribute__((ext_vector_type(2)));
template <class Epi, class Sched, bool STAMP = false>
__device__ __forceinline__ void gemm_phase(PG8_LAS unsigned char* lds, const Gemm g, const Sched& S, const Epi& E, unsigned long long* stamps) {
    const int tid = threadIdx.x, wid = __builtin_amdgcn_readfirstlane(tid >> 6), lane = tid & 63, wr = wid >> 2, wc = wid & 3, fr = lane & 15, fq = lane >> 4;
    const int K = g.K, nt = K / BK;
    int ts_lo = 0, ts_hi = 0, nts = 0; const unsigned long long rt_entry = STAMP ? (unsigned long long)wall_clock64() : 0ull;
#define PG8_STAMP() do { if (STAMP && wid == 0 && nts < 64) { const unsigned long long _c = (unsigned long long)clock64(); \
        ts_lo = (lane == nts) ? (int)(unsigned)_c : ts_lo; ts_hi = (lane == nts) ? (int)(unsigned)(_c >> 32) : ts_hi; ++nts; } } while (0)
    PG8_STAMP();
    unsigned voffA[2], voffB[2];
#pragma unroll
    for (int i = 0; i < 2; ++i) { int R, C; stage_rc(tid * 16 + i * 8192, R, C); const int Rb = Epi::PERM ? ((R & ~31) + perm32(R & 31)) : R;
        voffA[i] = (unsigned)(R * K + C) * 2u; voffB[i] = (unsigned)(Rb * K + C) * 2u; }
    const size_t kstep = (size_t)(BK * 2);
    const size_t hstep = (size_t)HALF * K * 2;
    const size_t tstep = 2 * hstep;
    const unsigned ldsw = (unsigned)wid * 1024u;
    const int aoff = lds_byte(wr * 64 + fr, fq * 8), boff = lds_byte(wc * 32 + fr, fq * 8);
#define PG8_SA(b, h) (((b) * 2 + (h)) * HTB)
#define PG8_SB(b, h) ((4 + (b) * 2 + (h)) * HTB)
#define PG8_STAGE(bufoff, gbase, voff) do { _Pragma("unroll") for (int _i = 0; _i < 2; ++_i) \
        __builtin_amdgcn_global_load_lds((const unsigned*)((const char*)(gbase) + (voff)[_i]), (PG8_LAS unsigned*)(lds + (bufoff) + ldsw + _i * 8192), 16, 0, 0); } while (0)
#define PG8_LDA(dst, b, h) do { _Pragma("unroll") for (int m = 0; m < 4; ++m) _Pragma("unroll") for (int k = 0; k < 2; ++k) dst[m][k] = *(const PG8_LAS bf16x8*)(lds + PG8_SA(b, h) + aoff + m * 2048 + k * 1024); } while (0)
#define PG8_LDB(dst, b, h) do { _Pragma("unroll") for (int n = 0; n < 2; ++n) _Pragma("unroll") for (int k = 0; k < 2; ++k) dst[n][k] = *(const PG8_LAS bf16x8*)(lds + PG8_SB(b, h) + boff + n * 2048 + k * 1024); } while (0)
#define PG8_MMA(ai, bj, At, Bt) do { __builtin_amdgcn_s_setprio(1); _Pragma("unroll") for (int m = 0; m < 4; ++m) _Pragma("unroll") for (int n = 0; n < 2; ++n) _Pragma("unroll") for (int k = 0; k < 2; ++k) \
        acc[ai][bj][m][n] = __builtin_amdgcn_mfma_f32_16x16x32_bf16(Bt[n][k], At[m][k], acc[ai][bj][m][n], 0, 0, 0); __builtin_amdgcn_s_setprio(0); } while (0)
#define PG8_WAIT_V(n) asm volatile("s_waitcnt vmcnt(" #n ")" ::: "memory")
#define PG8_WAIT_L(n) asm volatile("s_waitcnt lgkmcnt(" #n ")" ::: "memory")
#define PG8_BAR __builtin_amdgcn_s_barrier()
#define PG8_SCHED __builtin_amdgcn_sched_barrier(0)
    Unit cur, nxt; int ui = 0;
    if (!S.next(0, cur)) return;
    f32x4 acc[2][2][4][2];
#pragma unroll
    for (int a = 0; a < 2; ++a)
#pragma unroll
        for (int b = 0; b < 2; ++b)
#pragma unroll
            for (int m = 0; m < 4; ++m)
#pragma unroll
                for (int n = 0; n < 2; ++n) acc[a][b][m][n] = (f32x4){0.f, 0.f, 0.f, 0.f};
    bf16x8 At[4][2], B0[2][2], B1[2][2];
    const char* cA = (const char*)g.A + (size_t)cur.pm * tstep; const char* cB = (const char*)g.Bt + (size_t)cur.pn * tstep;
    S.a_ready(cur);
    PG8_STAGE(PG8_SB(0, 0), cB, voffB); PG8_STAGE(PG8_SA(0, 0), cA, voffA); PG8_STAGE(PG8_SB(0, 1), cB + hstep, voffB); PG8_STAGE(PG8_SA(0, 1), cA + hstep, voffA);
    if (wr == 1) PG8_BAR;
    PG8_WAIT_V(4); PG8_BAR;
    PG8_STAGE(PG8_SB(1, 0), cB + kstep, voffB); PG8_STAGE(PG8_SA(1, 0), cA + kstep, voffA); PG8_STAGE(PG8_SB(1, 1), cB + hstep + kstep, voffB);
    PG8_WAIT_V(6); PG8_BAR;
    PG8_STAMP();
    for (;;) {
        const bool has_next = S.next(ui + 1, nxt);
        const char* nA = has_next ? (const char*)g.A + (size_t)nxt.pm * tstep : cA; const char* nB = has_next ? (const char*)g.Bt + (size_t)nxt.pn * tstep : cB;
        for (int t = 0; t < nt; t += 2) {
            const bool last = (t == nt - 2);
            const char* a1 = cA + (size_t)(t + 1) * kstep;
            const char* a2 = last ? nA : cA + (size_t)(t + 2) * kstep; const char* b2 = last ? nB : cB + (size_t)(t + 2) * kstep;
            const char* a3 = a2 + kstep; const char* b3 = b2 + kstep;
            if (last && has_next) S.a_ready(nxt);
            PG8_LDB(B0, 0, 0); PG8_SCHED; PG8_LDA(At, 0, 0); PG8_STAGE(PG8_SA(1, 1), a1 + hstep, voffA);
            PG8_WAIT_L(8); PG8_BAR; PG8_WAIT_L(0); PG8_MMA(0, 0, At, B0); PG8_BAR; PG8_SCHED;
            PG8_LDB(B1, 0, 1); PG8_STAGE(PG8_SB(0, 0), b2, voffB);
            PG8_BAR; PG8_WAIT_L(0); PG8_MMA(0, 1, At, B1); PG8_BAR;
            PG8_LDA(At, 0, 1); PG8_STAGE(PG8_SA(0, 0), a2, voffA);
            PG8_BAR; PG8_WAIT_L(0); PG8_MMA(1, 0, At, B0); PG8_BAR; PG8_SCHED;
            PG8_STAGE(PG8_SB(0, 1), b2 + hstep, voffB);
            PG8_WAIT_V(6); PG8_BAR; PG8_MMA(1, 1, At, B1); PG8_BAR;
            PG8_LDB(B0, 1, 0); PG8_SCHED; PG8_LDA(At, 1, 0); PG8_STAGE(PG8_SA(0, 1), a2 + hstep, voffA);
            PG8_WAIT_L(8); PG8_BAR; PG8_WAIT_L(0); PG8_MMA(0, 0, At, B0); PG8_BAR; PG8_SCHED;
            PG8_LDB(B1, 1, 1); PG8_STAGE(PG8_SB(1, 0), b3, voffB);
            PG8_BAR; PG8_WAIT_L(0); PG8_MMA(0, 1, At, B1); PG8_BAR;
            PG8_LDA(At, 1, 1); PG8_STAGE(PG8_SA(1, 0), a3, voffA);
            PG8_BAR; PG8_WAIT_L(0); PG8_MMA(1, 0, At, B0); PG8_BAR; PG8_SCHED;
            PG8_STAGE(PG8_SB(1, 1), b3 + hstep, voffB);
            PG8_WAIT_V(6); PG8_BAR; PG8_MMA(1, 1, At, B1); PG8_BAR;
        }
        PG8_STAMP();
        if constexpr (!Epi::AFTER_DRAIN) { E(acc, cur, wr, wc, fr, fq); S.done(cur); }
        PG8_STAMP();
        if (!has_next) break;
#pragma unroll
        for (int a = 0; a < 2; ++a)
#pragma unroll
            for (int b = 0; b < 2; ++b)
#pragma unroll
                for (int m = 0; m < 4; ++m)
#pragma unroll
                    for (int n = 0; n < 2; ++n) acc[a][b][m][n] = (f32x4){0.f, 0.f, 0.f, 0.f};
        cur = nxt; cA = nA; cB = nB; ++ui;
    }
    PG8_WAIT_V(0);
    if (wr == 0) PG8_BAR;
    PG8_BAR;
    if constexpr (Epi::AFTER_DRAIN) { E.fused(acc, cur, wr, wc, fr, fq, lds, wid, lane); S.done(cur); }
    PG8_STAMP();
    if (STAMP && wid == 0) { stamps[lane] = lane < nts ? (((unsigned long long)(unsigned)ts_hi << 32) | (unsigned)ts_lo) : 0ull;
        if (lane == 62) stamps[62] = rt_entry; if (lane == 63) stamps[63] = (unsigned long long)wall_clock64(); }
#undef PG8_STAMP
#undef PG8_SA
#undef PG8_SB
#undef PG8_STAGE
#undef PG8_LDA
#undef PG8_LDB
#undef PG8_MMA
#undef PG8_WAIT_V
#undef PG8_WAIT_L
#undef PG8_BAR
#undef PG8_SCHED
}
}

using pg8::bf16_t;
typedef float f4 __attribute__((ext_vector_type(4)));

constexpr int D = 1024, NBP = 8, LP = 2064, NSB = 128, LS = 8, NMETA = 16;
constexpr int T_P = NBP * LP, T = T_P + NSB * LS, MP = 17664;
constexpr int DI = 2048, CD = 3072, NH = 32, DSTATE = 128, DFF = 2816, NINP = 5376, NUG = 5632;
constexpr float EPS = 1e-5f;

constexpr size_t O0 = 0, O1 = O0 + (size_t)8 * 2048 * 1024, O2 = O1 + (size_t)128 * 8 * 1024, O3 = O2 + 8 * 2 * 1024, O4 = O3 + 8 * 3 * 3072,
                 O5 = O4 + (size_t)8 * 32 * 64 * 128, O6 = O5 + 2 * 8 * 2 * 2816, O7 = O6 + 128 * 2 * 1024, O8 = O7 + 128 * 3 * 3072,
                 O9 = O8 + (size_t)128 * 32 * 64 * 128, OEND = O9 + 2 * 128 * 2 * 2816;

constexpr size_t al256(size_t x) { return (x + 255) & ~(size_t)255; }
constexpr size_t W_SC_IN = 0, W_SC_OUT = W_SC_IN + (size_t)3072 * 1024 * 2, W_UG0 = W_SC_OUT + (size_t)1024 * 1024 * 2, W_UG1 = W_UG0 + (size_t)NUG * 1024 * 2,
                 W_DN0 = W_UG1 + (size_t)NUG * 1024 * 2, W_DN1 = W_DN0 + (size_t)1024 * DFF * 2, W_SSM_IN = W_DN1 + (size_t)1024 * DFF * 2,
                 W_SSM_OUT = W_SSM_IN + (size_t)NINP * 1024 * 2, W_X = W_SSM_OUT + (size_t)1024 * 2048 * 2, W_XB = W_X + (size_t)MP * 1024 * 4,
                 W_BIG = W_XB + (size_t)MP * 1024 * 2, W_ABUF = W_BIG + (size_t)MP * NUG * 2, W_DTRAW = W_ABUF + (size_t)MP * 3072 * 2,
                 W_DTS = W_DTRAW + (size_t)MP * 32 * 4, W_SS = W_DTS + (size_t)MP * 32 * 4, W_END = W_SS + (size_t)5 * MP * 4;

struct Params { const float* in[25]; float* out; unsigned char* ws; int ph_lo, ph_hi; };

__device__ __forceinline__ void unpack8(const uint4 v, float* f) {
    f[0] = __uint_as_float(v.x << 16); f[1] = __uint_as_float(v.x & 0xffff0000u); f[2] = __uint_as_float(v.y << 16); f[3] = __uint_as_float(v.y & 0xffff0000u);
    f[4] = __uint_as_float(v.z << 16); f[5] = __uint_as_float(v.z & 0xffff0000u); f[6] = __uint_as_float(v.w << 16); f[7] = __uint_as_float(v.w & 0xffff0000u);
}
__device__ __forceinline__ uint4 pack8(const float* f) {
    uint4 r; r.x = pg8::cvt_pk_bf16(f[0], f[1]); r.y = pg8::cvt_pk_bf16(f[2], f[3]); r.z = pg8::cvt_pk_bf16(f[4], f[5]); r.w = pg8::cvt_pk_bf16(f[6], f[7]); return r;
}
__device__ __forceinline__ void load8f(const float* q, float* f) { const f4 a = *(const f4*)q, b = *(const f4*)(q + 4); f[0] = a.x; f[1] = a.y; f[2] = a.z; f[3] = a.w; f[4] = b.x; f[5] = b.y; f[6] = b.z; f[7] = b.w; }
__device__ __forceinline__ void store8f(float* q, const float* f) { *(f4*)q = (f4){f[0], f[1], f[2], f[3]}; *(f4*)(q + 4) = (f4){f[4], f[5], f[6], f[7]}; }
__device__ __forceinline__ float silu_f(float x) { return x / (1.0f + __expf(-x)); }
__device__ __forceinline__ void row_decode(int row, int& isP, int& b, int& t) {
    if (row < T_P) { isP = 1; b = row / LP; t = row - b * LP; } else { isP = 0; const int r = row - T_P; b = r >> 3; t = r & 7; }
}

struct EpiScale {
    static constexpr bool PERM = true, AFTER_DRAIN = false;
    bf16_t* O0; int ld0, ncol0; bf16_t* O1; int ld1, ncol1; float* DT; const float* ss;
    __device__ __forceinline__ void operator()(const pg8::f32x4 (&acc)[2][2][4][2], const pg8::Unit& u, int wr, int wc, int fr, int fq) const {
        const int row0 = u.pm * 256 + wr * 64 + fr; const int colt = u.pn * 256;
        bf16_t* base; int ld; bool isdt = false;
        if (colt < ncol0) { base = O0 + colt; ld = ld0; } else if (colt < ncol0 + ncol1) { base = O1 + (colt - ncol0); ld = ld1; } else { base = O0; ld = 0; isdt = true; }
        const int col0 = wc * 32 + 8 * fq;
#pragma unroll
        for (int ai = 0; ai < 2; ++ai)
#pragma unroll
            for (int m = 0; m < 4; ++m) {
                const int row = row0 + ai * 128 + m * 16;
                const float rs = __builtin_amdgcn_rsqf(ss[row] * (1.0f / 1024.0f) + EPS);
                if (!isdt) {
                    bf16_t* rowp = base + (size_t)row * ld + col0;
#pragma unroll
                    for (int bj = 0; bj < 2; ++bj) {
                        const pg8::f32x4 v0 = acc[ai][bj][m][0] * rs, v1 = acc[ai][bj][m][1] * rs;
                        pg8::u32x4 w; w.x = pg8::cvt_pk_bf16(v0[0], v0[1]); w.y = pg8::cvt_pk_bf16(v0[2], v0[3]); w.z = pg8::cvt_pk_bf16(v1[0], v1[1]); w.w = pg8::cvt_pk_bf16(v1[2], v1[3]);
                        *(pg8::u32x4*)(rowp + bj * 128) = w;
                    }
                } else if (wc == 0) {
                    float* q = DT + (size_t)row * 32 + 8 * fq;
                    *(pg8::f32x4*)q = acc[ai][0][m][0] * rs; *(pg8::f32x4*)(q + 4) = acc[ai][0][m][1] * rs;
                }
            }
    }
};
struct EpiResid {
    static constexpr bool PERM = true, AFTER_DRAIN = false;
    float* X; bf16_t* Xb; float* ssn;
    __device__ __forceinline__ void operator()(const pg8::f32x4 (&acc)[2][2][4][2], const pg8::Unit& u, int wr, int wc, int fr, int fq) const {
        const int row0 = u.pm * 256 + wr * 64 + fr; const int col0 = u.pn * 256 + wc * 32 + 8 * fq;
#pragma unroll
        for (int ai = 0; ai < 2; ++ai)
#pragma unroll
            for (int m = 0; m < 4; ++m) {
                const int row = row0 + ai * 128 + m * 16; float s = 0.f;
#pragma unroll
                for (int bj = 0; bj < 2; ++bj) {
                    float* xp = X + (size_t)row * 1024 + col0 + bj * 128;
                    pg8::f32x4 v0 = *(pg8::f32x4*)xp, v1 = *(pg8::f32x4*)(xp + 4);
                    v0 += acc[ai][bj][m][0]; v1 += acc[ai][bj][m][1];
                    *(pg8::f32x4*)xp = v0; *(pg8::f32x4*)(xp + 4) = v1;
                    pg8::u32x4 w; w.x = pg8::cvt_pk_bf16(v0[0], v0[1]); w.y = pg8::cvt_pk_bf16(v0[2], v0[3]); w.z = pg8::cvt_pk_bf16(v1[0], v1[1]); w.w = pg8::cvt_pk_bf16(v1[2], v1[3]);
                    *(pg8::u32x4*)(Xb + (size_t)row * 1024 + col0 + bj * 128) = w;
                    s += v0[0] * v0[0] + v0[1] * v0[1] + v0[2] * v0[2] + v0[3] * v0[3] + v1[0] * v1[0] + v1[1] * v1[1] + v1[2] * v1[2] + v1[3] * v1[3];
                }
                s += __shfl_xor(s, 16); s += __shfl_xor(s, 32);
                if (fq == 0) atomicAdd(ssn + row, s);
            }
    }
};
template <class Epi> __device__ __forceinline__ void run_gemm(PG8_LAS unsigned char* lds, const bf16_t* A, const bf16_t* Bt, int N, int K, const Epi& E) {
    pg8::Gemm g{A, Bt, MP, N, K}; pg8::StaticOrder S; S.init(MP, N, (int)gridDim.x, (int)blockIdx.x);
    pg8::gemm_phase<Epi, pg8::StaticOrder, false>(lds, g, S, E, nullptr);
}

__device__ void phase_prep(const Params& p, float* tile  ) {
    const int tid = threadIdx.x; unsigned char* ws = p.ws;
    constexpr int NJ = 10;
    const int jt[NJ + 1] = {0, 768, 1024, 1728, 2432, 3136, 3840, 4544, 5248, 6592, 7104};
    for (int gt = blockIdx.x; gt < 7104; gt += gridDim.x) {
        int j = 0;
#pragma unroll
        for (int q = 1; q < NJ; ++q) if (gt >= jt[q]) j = q;
        const int lt = gt - jt[j];
        const float* src; const float* scale = nullptr; bf16_t* dst; int K = 1024, N, Npad;
        switch (j) {
            case 0: src = p.in[10]; scale = p.in[7]; dst = (bf16_t*)(ws + W_SC_IN); N = 3072; Npad = 3072; break;
            case 1: src = p.in[12]; dst = (bf16_t*)(ws + W_SC_OUT); N = 1024; Npad = 1024; break;
            case 2: src = p.in[21]; scale = p.in[8]; dst = (bf16_t*)(ws + W_UG0); N = DFF; Npad = DFF; break;
            case 3: src = p.in[21] + (size_t)1024 * DFF; scale = p.in[8] + 1024; dst = (bf16_t*)(ws + W_UG1); N = DFF; Npad = DFF; break;
            case 4: src = p.in[22]; scale = p.in[8]; dst = (bf16_t*)(ws + W_UG0) + (size_t)DFF * 1024; N = DFF; Npad = DFF; break;
            case 5: src = p.in[22] + (size_t)1024 * DFF; scale = p.in[8] + 1024; dst = (bf16_t*)(ws + W_UG1) + (size_t)DFF * 1024; N = DFF; Npad = DFF; break;
            case 6: src = p.in[24]; dst = (bf16_t*)(ws + W_DN0); K = DFF; N = 1024; Npad = 1024; break;
            case 7: src = p.in[24] + (size_t)DFF * 1024; dst = (bf16_t*)(ws + W_DN1); K = DFF; N = 1024; Npad = 1024; break;
            case 8: src = p.in[13]; scale = p.in[7] + 1024; dst = (bf16_t*)(ws + W_SSM_IN); N = 5152; Npad = NINP; break;
            default: src = p.in[20]; dst = (bf16_t*)(ws + W_SSM_OUT); K = 2048; N = 1024; Npad = 1024; break;
        }
        const int ntn = Npad / 64; const int k0 = (lt / ntn) * 64, n0 = (lt % ntn) * 64;
        __syncthreads();
#pragma unroll
        for (int i = 0; i < 8; ++i) {
            const int kk = i * 8 + (tid >> 6), nn = tid & 63; float v = 0.f;
            if (n0 + nn < N) { v = src[(size_t)(k0 + kk) * N + n0 + nn]; if (scale) v *= scale[k0 + kk]; }
            tile[kk * 65 + nn] = v;
        }
        __syncthreads();
#pragma unroll
        for (int i = 0; i < 4; ++i) {
            const int nn = i * 16 + (tid >> 5), kk = (tid & 31) * 2;
            *(unsigned*)(dst + (size_t)(n0 + nn) * K + k0 + kk) = pg8::cvt_pk_bf16(tile[kk * 65 + nn], tile[(kk + 1) * 65 + nn]);
        }
    }
    float* X = (float*)(ws + W_X); bf16_t* Xb = (bf16_t*)(ws + W_XB); float* SS = (float*)(ws + W_SS);
    const int lane = tid & 63, wv = tid >> 6;
    for (int row = blockIdx.x * 8 + wv; row < MP; row += gridDim.x * 8) {
        const float* src = nullptr;
        if (row < T_P) { const int b = row / LP, t = row - b * LP; src = t < NMETA ? p.in[6] + (size_t)t * 1024 : p.in[0] + ((size_t)b * 2048 + (t - NMETA)) * 1024; }
        else if (row < T) src = p.in[1] + (size_t)(row - T_P) * 1024;
        float s = 0.f;
#pragma unroll
        for (int i = 0; i < 4; ++i) {
            const int c = i * 256 + lane * 4; f4 v = (f4){0.f, 0.f, 0.f, 0.f};
            if (src) v = *(const f4*)(src + c);
            *(f4*)(X + (size_t)row * 1024 + c) = v;
            uint2 w; w.x = pg8::cvt_pk_bf16(v.x, v.y); w.y = pg8::cvt_pk_bf16(v.z, v.w); *(uint2*)(Xb + (size_t)row * 1024 + c) = w;
            s += v.x * v.x + v.y * v.y + v.z * v.z + v.w * v.w;
        }
#pragma unroll
        for (int o = 32; o >= 1; o >>= 1) s += __shfl_xor(s, o);
        if (lane == 0) { SS[row] = s; SS[MP + row] = 0.f; SS[2 * MP + row] = 0.f; SS[3 * MP + row] = 0.f; SS[4 * MP + row] = 0.f; }
    }
}

__device__ void phase_sc_conv(const Params& p) {
    const bf16_t* BCX = (const bf16_t*)(p.ws + W_BIG); bf16_t* A1 = (bf16_t*)(p.ws + W_ABUF);
    const float* cw = p.in[11]; const float* cache = p.in[2];
    for (int idx = blockIdx.x * 512 + threadIdx.x; idx < T * 128; idx += gridDim.x * 512) {
        const int row = idx >> 7, c = (idx & 127) * 8; int isP, b, t; row_decode(row, isP, b, t);
        float acc[8], cur[8];
#pragma unroll
        for (int j = 0; j < 8; ++j) { acc[j] = 0.f; cur[j] = 0.f; }
#pragma unroll
        for (int k = 0; k < 3; ++k) {
            const int tp = t - 2 + k; float cx[8];
            if (tp >= 0) { const bf16_t* r = BCX + (size_t)(row - 2 + k) * 3072 + c; float cg_[8], xv[8]; unpack8(*(const uint4*)(r + 1024), cg_); unpack8(*(const uint4*)(r + 2048), xv);
#pragma unroll
                for (int j = 0; j < 8; ++j) cx[j] = cg_[j] * xv[j]; }
            else if (!isP) load8f(cache + ((size_t)b * 2 + (2 + tp)) * 1024 + c, cx);
            else {
#pragma unroll
                for (int j = 0; j < 8; ++j) cx[j] = 0.f; }
            float w[8]; load8f(cw + k * 1024 + c, w);
#pragma unroll
            for (int j = 0; j < 8; ++j) { acc[j] += w[j] * cx[j]; if (k == 2) cur[j] = cx[j]; }
        }
        float bg[8]; unpack8(*(const uint4*)(BCX + (size_t)row * 3072 + c), bg);
#pragma unroll
        for (int j = 0; j < 8; ++j) acc[j] *= bg[j];
        *(uint4*)(A1 + (size_t)row * 1024 + c) = pack8(acc);
        const int Lr = isP ? LP : LS;
        if (t >= Lr - 2) store8f(p.out + (isP ? O2 : O6) + ((size_t)b * 2 + (t - (Lr - 2))) * 1024 + c, cur);
    }
}
__device__ void phase_ffn_conv(const Params& p, int li) {
    const bf16_t* UG = (const bf16_t*)(p.ws + W_BIG); bf16_t* A2 = (bf16_t*)(p.ws + W_ABUF);
    const float* cw = p.in[23] + (size_t)li * 3 * DFF; const float* cache = p.in[5] + (size_t)li * NSB * 2 * DFF;
    for (int idx = blockIdx.x * 512 + threadIdx.x; idx < T * 352; idx += gridDim.x * 512) {
        const int row = idx / 352, c = (idx - row * 352) * 8; int isP, b, t; row_decode(row, isP, b, t);
        float acc[8], cur[8];
#pragma unroll
        for (int j = 0; j < 8; ++j) { acc[j] = 0.f; cur[j] = 0.f; }
#pragma unroll
        for (int k = 0; k < 3; ++k) {
            const int tp = t - 2 + k; float uu[8];
            if (tp >= 0) unpack8(*(const uint4*)(UG + (size_t)(row - 2 + k) * NUG + c), uu);
            else if (!isP) load8f(cache + ((size_t)b * 2 + (2 + tp)) * DFF + c, uu);
            else {
#pragma unroll
                for (int j = 0; j < 8; ++j) uu[j] = 0.f; }
            float w[8]; load8f(cw + k * DFF + c, w);
#pragma unroll
            for (int j = 0; j < 8; ++j) { acc[j] += w[j] * uu[j]; if (k == 2) cur[j] = uu[j]; }
        }
        float g[8]; unpack8(*(const uint4*)(UG + (size_t)row * NUG + DFF + c), g);
#pragma unroll
        for (int j = 0; j < 8; ++j) acc[j] = silu_f(acc[j]) * g[j];
        *(uint4*)(A2 + (size_t)row * DFF + c) = pack8(acc);
        const int Lr = isP ? LP : LS;
        if (t >= Lr - 2) store8f(p.out + (isP ? O5 + ((size_t)(li * NBP + b) * 2 + (t - (Lr - 2))) * DFF : O9 + ((size_t)(li * NSB + b) * 2 + (t - (Lr - 2))) * DFF) + c, cur);
    }
}
__device__ void phase_ssm_conv(const Params& p) {
    const bf16_t* XBC = (const bf16_t*)(p.ws + W_BIG) + (size_t)MP * 2048; bf16_t* XC = (bf16_t*)(p.ws + W_ABUF);
    const float* cw = p.in[14]; const float* cb = p.in[15]; const float* cache = p.in[3];
    const float* DTR = (const float*)(p.ws + W_DTRAW); float* DTS = (float*)(p.ws + W_DTS); const float* dtb = p.in[16];
    for (int idx = blockIdx.x * 512 + threadIdx.x; idx < T * 384; idx += gridDim.x * 512) {
        const int row = idx / 384, cc = idx - row * 384, c = cc * 8; int isP, b, t; row_decode(row, isP, b, t);
        float acc[8], cur[8];
        load8f(cb + c, acc);
#pragma unroll
        for (int j = 0; j < 8; ++j) cur[j] = 0.f;
#pragma unroll
        for (int k = 0; k < 4; ++k) {
            const int tp = t - 3 + k; float uu[8];
            if (tp >= 0) unpack8(*(const uint4*)(XBC + (size_t)(row - 3 + k) * 3072 + c), uu);
            else if (!isP) load8f(cache + ((size_t)b * 3 + (3 + tp)) * 3072 + c, uu);
            else {
#pragma unroll
                for (int j = 0; j < 8; ++j) uu[j] = 0.f; }
            float w[8]; load8f(cw + k * 3072 + c, w);
#pragma unroll
            for (int j = 0; j < 8; ++j) { acc[j] += w[j] * uu[j]; if (k == 3) cur[j] = uu[j]; }
        }
#pragma unroll
        for (int j = 0; j < 8; ++j) acc[j] = silu_f(acc[j]);
        *(uint4*)(XC + (size_t)row * 3072 + c) = pack8(acc);
        const int Lr = isP ? LP : LS;
        if (t >= Lr - 3) store8f(p.out + (isP ? O3 : O7) + ((size_t)b * 3 + (t - (Lr - 3))) * 3072 + c, cur);
        if (cc < 4) {
            float v[8], bb[8]; load8f(DTR + (size_t)row * 32 + c, v); load8f(dtb + c, bb);
#pragma unroll
            for (int j = 0; j < 8; ++j) { const float z = v[j] + bb[j]; v[j] = z > 20.f ? z : log1pf(__expf(z)); }
            store8f(DTS + (size_t)row * 32 + c, v);
        }
    }
}
__device__ void phase_ssd(const Params& p, float* lds) {
    const bf16_t* XC = (const bf16_t*)(p.ws + W_ABUF); const bf16_t* Z = (const bf16_t*)(p.ws + W_BIG); bf16_t* Y = (bf16_t*)(p.ws + W_BIG) + (size_t)MP * 2048;
    const float* DTS = (const float*)(p.ws + W_DTS);
    float* Bs = lds; float* Cs = lds + 4096; float* xs = lds + 8192; float* zs = lds + 10240; float* dts = lds + 12288;
    const int tid = threadIdx.x, pp = tid >> 3, jj = tid & 7;
    for (int item = blockIdx.x; item < 256 + NSB * NH; item += gridDim.x) {
        int isP, b, h;
        if (item < 256) { isP = 1; b = item >> 5; h = item & 31; } else { isP = 0; b = (item - 256) >> 5; h = (item - 256) & 31; }
        const int g = h >> 3; const int row0 = isP ? b * LP : T_P + b * LS; const int L = isP ? LP : LS;
        const float a = -__expf(p.in[17][h]); const float dsk = p.in[18][h];
        f4 S[4];
        if (isP) {
#pragma unroll
            for (int i = 0; i < 4; ++i) S[i] = (f4){0.f, 0.f, 0.f, 0.f};
        } else {
            const float* s0 = p.in[4] + ((size_t)(b * NH + h) * 64 + pp) * 128 + 4 * jj;
#pragma unroll
            for (int i = 0; i < 4; ++i) S[i] = *(const f4*)(s0 + 32 * i);
        }
        for (int t0 = 0; t0 < L; t0 += 32) {
            const int nt = (L - t0) < 32 ? (L - t0) : 32;
            __syncthreads();
            {
                const int tk = tid >> 4, n8 = (tid & 15) * 8; float f[8];
                if (tk < nt) {
                    const bf16_t* r = XC + (size_t)(row0 + t0 + tk) * 3072 + 2048 + g * 128 + n8;
                    unpack8(*(const uint4*)r, f); store8f(Bs + tk * 128 + n8, f);
                    unpack8(*(const uint4*)(r + 512), f); store8f(Cs + tk * 128 + n8, f);
                }
                const int t2 = (tid & 255) >> 3, p8 = (tid & 7) * 8;
                if (t2 < nt) {
                    if (tid < 256) { unpack8(*(const uint4*)(XC + (size_t)(row0 + t0 + t2) * 3072 + h * 64 + p8), f); store8f(xs + t2 * 64 + p8, f); }
                    else { unpack8(*(const uint4*)(Z + (size_t)(row0 + t0 + t2) * 2048 + h * 64 + p8), f); store8f(zs + t2 * 64 + p8, f); }
                }
                if (tid < nt) dts[tid] = DTS[(size_t)(row0 + t0 + tid) * 32 + h];
            }
            __syncthreads();
            for (int tk = 0; tk < nt; ++tk) {
                const float dt = dts[tk], dA = __expf(dt * a), xv = xs[tk * 64 + pp], w = dt * xv;
                float y = 0.f;
#pragma unroll
                for (int i = 0; i < 4; ++i) {
                    const f4 Bv = *(const f4*)(Bs + tk * 128 + 32 * i + 4 * jj), Cv = *(const f4*)(Cs + tk * 128 + 32 * i + 4 * jj);
                    S[i] = S[i] * dA + Bv * w;
                    y += Cv.x * S[i].x + Cv.y * S[i].y + Cv.z * S[i].z + Cv.w * S[i].w;
                }
                y += __shfl_xor(y, 1); y += __shfl_xor(y, 2); y += __shfl_xor(y, 4);
                if (jj == 0) {
                    const float zv = zs[tk * 64 + pp]; float yv = (y + dsk * xv) * silu_f(zv);
                    Y[(size_t)(row0 + t0 + tk) * 2048 + h * 64 + pp] = (bf16_t)(pg8::cvt_pk_bf16(yv, 0.f) & 0xffffu);
                }
            }
        }
        float* so = p.out + (isP ? O4 : O8) + ((size_t)(b * NH + h) * 64 + pp) * 128 + 4 * jj;
#pragma unroll
        for (int i = 0; i < 4; ++i) *(f4*)(so + 32 * i) = S[i];
    }
}
__device__ void phase_gnorm(const Params& p) {
    bf16_t* Y = (bf16_t*)(p.ws + W_BIG) + (size_t)MP * 2048; const float* nw = p.in[19];
    const int lane = threadIdx.x & 63, wv = threadIdx.x >> 6;
    for (int row = blockIdx.x * 8 + wv; row < T; row += gridDim.x * 8) {
        bf16_t* r = Y + (size_t)row * 2048 + lane * 32; float v[4][8]; float s = 0.f;
#pragma unroll
        for (int i = 0; i < 4; ++i) { unpack8(*(const uint4*)(r + i * 8), v[i]);
#pragma unroll
            for (int j = 0; j < 8; ++j) s += v[i][j] * v[i][j]; }
        s += __shfl_xor(s, 1); s += __shfl_xor(s, 2); s += __shfl_xor(s, 4); s += __shfl_xor(s, 8);
        const float rs = __builtin_amdgcn_rsqf(s * (1.0f / 512.0f) + EPS);
#pragma unroll
        for (int i = 0; i < 4; ++i) { float w[8]; load8f(nw + lane * 32 + i * 8, w);
#pragma unroll
            for (int j = 0; j < 8; ++j) v[i][j] *= rs * w[j];
            *(uint4*)(r + i * 8) = pack8(v[i]); }
    }
}
__device__ void phase_final(const Params& p) {
    const float* X = (const float*)(p.ws + W_X); const float* SS4 = (const float*)(p.ws + W_SS) + 4 * (size_t)MP; const float* nw = p.in[9];
    const int lane = threadIdx.x & 63, wv = threadIdx.x >> 6;
    for (int row = blockIdx.x * 8 + wv; row < T; row += gridDim.x * 8) {
        int isP, b, t; row_decode(row, isP, b, t);
        if (isP && t < NMETA) continue;
        float* o = isP ? p.out + O0 + ((size_t)b * 2048 + (t - NMETA)) * 1024 : p.out + O1 + (size_t)(row - T_P) * 1024;
        const float rs = __builtin_amdgcn_rsqf(SS4[row] * (1.0f / 1024.0f) + EPS);
#pragma unroll
        for (int i = 0; i < 4; ++i) { const int c = i * 256 + lane * 4; const f4 v = *(const f4*)(X + (size_t)row * 1024 + c), w = *(const f4*)(nw + c); *(f4*)(o + c) = v * rs * w; }
    }
}

constexpr int NPHASE = 16, LDS_BYTES = 131072;
__global__ void __launch_bounds__(512) fwd_megakernel(Params p) {
    extern __shared__ __attribute__((aligned(16))) unsigned char shm[];
    cg::grid_group grid = cg::this_grid();
    unsigned char* ws = p.ws;
    bf16_t* XB = (bf16_t*)(ws + W_XB); bf16_t* BIG = (bf16_t*)(ws + W_BIG); bf16_t* ABUF = (bf16_t*)(ws + W_ABUF); float* SS = (float*)(ws + W_SS);
#define PHASE(n, ...) if (p.ph_lo <= (n) && (n) < p.ph_hi) { __VA_ARGS__; if ((n) + 1 < p.ph_hi) grid.sync(); }
#define GEMM_S(n, WOFF, NN, LD0, NC0, O1P, LD1, NC1, SSI) PHASE(n, { EpiScale E; E.O0 = BIG; E.ld0 = LD0; E.ncol0 = NC0; E.O1 = O1P; E.ld1 = LD1; E.ncol1 = NC1; E.DT = (float*)(ws + W_DTRAW); E.ss = SS + (size_t)(SSI) * MP; \
        run_gemm((PG8_LAS unsigned char*)shm, XB, (const bf16_t*)(ws + WOFF), NN, 1024, E); })
#define GEMM_R(n, AP, WOFF, KK, SSI) PHASE(n, { EpiResid E; E.X = (float*)(ws + W_X); E.Xb = XB; E.ssn = SS + (size_t)(SSI) * MP; \
        run_gemm((PG8_LAS unsigned char*)shm, AP, (const bf16_t*)(ws + WOFF), 1024, KK, E); })
    PHASE(0, phase_prep(p, (float*)shm))
    GEMM_S(1, W_SC_IN, 3072, 3072, 3072, BIG, 0, 0, 0)
    PHASE(2, phase_sc_conv(p))
    GEMM_R(3, ABUF, W_SC_OUT, 1024, 1)
    GEMM_S(4, W_UG0, NUG, NUG, NUG, BIG, 0, 0, 1)
    PHASE(5, phase_ffn_conv(p, 0))
    GEMM_R(6, ABUF, W_DN0, DFF, 2)
    GEMM_S(7, W_SSM_IN, NINP, 2048, 2048, BIG + (size_t)MP * 2048, 3072, 3072, 2)
    PHASE(8, phase_ssm_conv(p))
    PHASE(9, phase_ssd(p, (float*)shm))
    PHASE(10, phase_gnorm(p))
    GEMM_R(11, BIG + (size_t)MP * 2048, W_SSM_OUT, 2048, 3)
    GEMM_S(12, W_UG1, NUG, NUG, NUG, BIG, 0, 0, 3)
    PHASE(13, phase_ffn_conv(p, 1))
    GEMM_R(14, ABUF, W_DN1, DFF, 4)
    PHASE(15, phase_final(p))
}

extern "C" void kernel_launch(void* const* d_in, const int* in_sizes, int n_in, void* d_out, int out_size, void* d_ws, size_t ws_size, hipStream_t stream) {
    static int grid_blocks = 0;
    if (grid_blocks == 0) {
        if (n_in != 25 || (size_t)out_size != OEND || ws_size < W_END) { fprintf(stderr, "kernel_launch: unexpected shapes: n_in %d out %d ws %zu (need %zu)\n", n_in, out_size, ws_size, (size_t)W_END); grid_blocks = -1; return; }
        int dev = 0, cus = 0, per_cu = 0;
        hipGetDevice(&dev); hipDeviceGetAttribute(&cus, hipDeviceAttributeMultiprocessorCount, dev);
        if (hipFuncSetAttribute((const void*)fwd_megakernel, hipFuncAttributeMaxDynamicSharedMemorySize, LDS_BYTES) != hipSuccess) { fprintf(stderr, "kernel_launch: hipFuncSetAttribute failed\n"); grid_blocks = -1; return; }
        if (hipOccupancyMaxActiveBlocksPerMultiprocessor(&per_cu, (const void*)fwd_megakernel, 512, LDS_BYTES) != hipSuccess || per_cu < 1) { fprintf(stderr, "kernel_launch: occupancy query gave %d\n", per_cu); per_cu = 1; }
        (void)hipGetLastError();
        grid_blocks = cus * 1;
    }
    if (grid_blocks < 0) return;
    Params p{};
    for (int i = 0; i < 25; ++i) p.in[i] = (const float*)d_in[i];
    p.out = (float*)d_out; p.ws = (unsigned char*)d_ws;
#ifdef MULTI_LAUNCH
    for (int ph = 0; ph < NPHASE; ++ph) { p.ph_lo = ph; p.ph_hi = ph + 1; hipLaunchKernelGGL(fwd_megakernel, dim3(grid_blocks), dim3(512), LDS_BYTES, stream, p); }
#else
    p.ph_lo = 0; p.ph_hi = NPHASE;
    void* args[] = {&p};
    hipError_t e = hipLaunchCooperativeKernel((const void*)fwd_megakernel, dim3(grid_blocks), dim3(512), args, LDS_BYTES, stream);
    if (e != hipSuccess) fprintf(stderr, "cooperative launch failed: %s (grid %d)\n", hipGetErrorString(e), grid_blocks);
#endif
}
```

```cpp
#include <hip/hip_runtime.h>
#include <hip/hip_cooperative_groups.h>
#include <cstdio>
namespace cg = cooperative_groups;
namespace pg8 {
#define PG8_LAS __attribute__((address_space(3)))
typedef unsigned short bf16_t;
typedef short bf16x8 __attribute__((ext_vector_type(8)));
typedef float f32x4 __attribute__((ext_vector_type(4)));
typedef unsigned u32x4 __attribute__((ext_vector_type(4)));
constexpr int BM = 256, BK = 64, HALF = 128, HTB = HALF * BK * 2  , STAGE_BYTES = 8 * HTB, NXCD = 8, WGM = 4;

__host__ __device__ __forceinline__ int lds_byte(int r, int c) { const int st = (r >> 4) * 2 + (c >> 5), rr = r & 15, cc = c & 31, ob = rr * 64 + cc * 2; return st * 1024 + (ob ^ (((ob >> 9) & 1) << 5)); }
__host__ __device__ __forceinline__ void stage_rc(int b, int& R, int& C) { const int st = b / 1024, sb = b % 1024, swz = sb ^ (((sb >> 9) & 1) << 5); R = (st >> 1) * 16 + swz / 64; C = (st & 1) * 32 + (swz % 64) / 2; }
__host__ __device__ __forceinline__ int perm32(int rho) { const int n = rho >> 4, i = rho & 15; return 8 * (i >> 2) + 4 * n + (i & 3); }

struct Unit { int pm, pn, q; };
struct Gemm { const bf16_t* A; const bf16_t* Bt; int M, N, K; };

struct StaticOrder {
    int nM, nN, nwg, G, c;
    __host__ __device__ void init(int M, int N, int G_, int c_) { nM = M / BM; nN = N / BM; nwg = nM * nN; G = G_; c = c_; }
    __host__ __device__ void map(int L, Unit& u) const {
        int wgid = L; { const int q = nwg / NXCD, r = nwg % NXCD, xcd = wgid % NXCD, off = wgid / NXCD; wgid = (xcd < r ? xcd * (q + 1) : r * (q + 1) + (xcd - r) * q) + off; }
        const int nig = WGM * nN, gid = wgid / nig, fm = gid * WGM, gsz = (nM - fm) < WGM ? (nM - fm) : WGM;
        u.pm = fm + ((wgid % nig) % gsz); u.pn = (wgid % nig) / gsz; u.q = -1;
    }
    __host__ __device__ bool next(int i, Unit& u) const {
        const long L = (long)i * G + c; if (L >= nwg) return false;
        map((int)L, u); return true;
    }
    __device__ __forceinline__ void a_ready(const Unit&) const {}
    __device__ __forceinline__ void done(const Unit&) const {}
};
struct TailOrder : StaticOrder {
    __device__ bool split() const { return nwg > G && nwg <= 2 * G && 4 * (nwg - G) <= G; }
    __device__ bool next(int i, Unit& u) const {
        if (!split()) return StaticOrder::next(i, u);
        if (i == 0) { map(c, u); return true; }
        const int nt4 = 4 * (nwg - G);
        if (i == 1 && c < nt4) {
            int unit, q;
            if ((nt4 & 15) == 0) { const int xcd = c & 7, slot = c >> 3, pair = xcd * (nt4 >> 4) + (slot >> 1); unit = pair >> 1; q = ((pair & 1) << 1) | (slot & 1); }
            else { unit = c >> 2; q = c & 3; }
            map(G + unit, u); u.q = q; return true;
        }
        return false;
    }
};

__device__ __forceinline__ unsigned cvt_pk_bf16(float lo, float hi) { unsigned r; asm volatile("v_cvt_pk_bf16_f32 %0, %1, %2" : "=v"(r) : "v"(lo), "v"(hi)); return r; }
typedef float f32x2 __attribute__((ext_vector_type(2)));
template <class Epi, class Sched, bool STAMP = false>
__device__ __forceinline__ void gemm_phase(PG8_LAS unsigned char* lds, const Gemm g, const Sched& S, const Epi& E, unsigned long long* stamps) {
    const int tid = threadIdx.x, wid = __builtin_amdgcn_readfirstlane(tid >> 6), lane = tid & 63, wr = wid >> 2, wc = wid & 3, fr = lane & 15, fq = lane >> 4;
    const int K = g.K, nt = K / BK;
    int ts_lo = 0, ts_hi = 0, nts = 0; const unsigned long long rt_entry = STAMP ? (unsigned long long)wall_clock64() : 0ull;
#define PG8_STAMP() do { if (STAMP && wid == 0 && nts < 64) { const unsigned long long _c = (unsigned long long)clock64(); \
        ts_lo = (lane == nts) ? (int)(unsigned)_c : ts_lo; ts_hi = (lane == nts) ? (int)(unsigned)(_c >> 32) : ts_hi; ++nts; } } while (0)
    PG8_STAMP();
    unsigned voffA[2], voffB[2];
#pragma unroll
    for (int i = 0; i < 2; ++i) { int R, C; stage_rc(tid * 16 + i * 8192, R, C); const int Rb = Epi::PERM ? ((R & ~31) + perm32(R & 31)) : R;
        voffA[i] = (unsigned)(R * K + C) * 2u; voffB[i] = (unsigned)(Rb * K + C) * 2u; }
    const size_t kstep = (size_t)(BK * 2);
    const size_t hstep = (size_t)HALF * K * 2;
    const size_t tstep = 2 * hstep;
    const unsigned ldsw = (unsigned)wid * 1024u;
    const int aoff = lds_byte(wr * 64 + fr, fq * 8), boff = lds_byte(wc * 32 + fr, fq * 8);
#define PG8_SA(b, h) (((b) * 2 + (h)) * HTB)
#define PG8_SB(b, h) ((4 + (b) * 2 + (h)) * HTB)
#define PG8_STAGE(bufoff, gbase, voff) do { _Pragma("unroll") for (int _i = 0; _i < 2; ++_i) \
        __builtin_amdgcn_global_load_lds((const unsigned*)((const char*)(gbase) + (voff)[_i]), (PG8_LAS unsigned*)(lds + (bufoff) + ldsw + _i * 8192), 16, 0, 0); } while (0)
#define PG8_LDA(dst, b, h) do { _Pragma("unroll") for (int m = 0; m < 4; ++m) _Pragma("unroll") for (int k = 0; k < 2; ++k) dst[m][k] = *(const PG8_LAS bf16x8*)(lds + PG8_SA(b, h) + aoff + m * 2048 + k * 1024); } while (0)
#define PG8_LDB(dst, b, h) do { _Pragma("unroll") for (int n = 0; n < 2; ++n) _Pragma("unroll") for (int k = 0; k < 2; ++k) dst[n][k] = *(const PG8_LAS bf16x8*)(lds + PG8_SB(b, h) + boff + n * 2048 + k * 1024); } while (0)
#define PG8_MMA(ai, bj, At, Bt) do { __builtin_amdgcn_s_setprio(1); _Pragma("unroll") for (int m = 0; m < 4; ++m) _Pragma("unroll") for (int n = 0; n < 2; ++n) _Pragma("unroll") for (int k = 0; k < 2; ++k) \
        acc[ai][bj][m][n] = __builtin_amdgcn_mfma_f32_16x16x32_bf16(Bt[n][k], At[m][k], acc[ai][bj][m][n], 0, 0, 0); __builtin_amdgcn_s_setprio(0); } while (0)
#define PG8_WAIT_V(n) asm volatile("s_waitcnt vmcnt(" #n ")" ::: "memory")
#define PG8_WAIT_L(n) asm volatile("s_waitcnt lgkmcnt(" #n ")" ::: "memory")
#define PG8_BAR __builtin_amdgcn_s_barrier()
#define PG8_SCHED __builtin_amdgcn_sched_barrier(0)
    Unit cur, nxt; int ui = 0;
    if (!S.next(0, cur)) return;
    f32x4 acc[2][2][4][2];
    float aux[8];
    E.pre(aux, cur, wr, wc, fr, fq);
    if constexpr (Epi::INIT_ACC) E.init(acc, cur, wr, wc, fr, fq);
    if constexpr (true) { asm volatile("" ::: "memory"); __builtin_amdgcn_sched_barrier(0); }
    if constexpr (!Epi::INIT_ACC) {
#pragma unroll
    for (int a = 0; a < 2; ++a)
#pragma unroll
        for (int b = 0; b < 2; ++b)
#pragma unroll
            for (int m = 0; m < 4; ++m)
#pragma unroll
                for (int n = 0; n < 2; ++n) acc[a][b][m][n] = (f32x4){0.f, 0.f, 0.f, 0.f};
    }
    bf16x8 At[4][2], B0[2][2], B1[2][2];
    const char* cA = (const char*)g.A + (size_t)cur.pm * tstep + (cur.q > 0 ? (size_t)(cur.q >> 1) * hstep : 0); const char* cB = (const char*)g.Bt + (size_t)cur.pn * tstep + (cur.q > 0 ? (size_t)(cur.q & 1) * hstep : 0);
    S.a_ready(cur);
    const size_t hs0 = cur.q < 0 ? hstep : 0;
    PG8_STAGE(PG8_SB(0, 0), cB, voffB); PG8_STAGE(PG8_SA(0, 0), cA, voffA); PG8_STAGE(PG8_SB(0, 1), cB + hs0, voffB); PG8_STAGE(PG8_SA(0, 1), cA + hs0, voffA);
    if (wr == 1) PG8_BAR;
    PG8_WAIT_V(4); PG8_BAR;
    PG8_STAGE(PG8_SB(1, 0), cB + kstep, voffB); PG8_STAGE(PG8_SA(1, 0), cA + kstep, voffA); PG8_STAGE(PG8_SB(1, 1), cB + hs0 + kstep, voffB);
    PG8_WAIT_V(6); PG8_BAR;
    PG8_STAMP();
    for (;;) {
        const bool has_next = S.next(ui + 1, nxt);
        const char* nA = has_next ? (const char*)g.A + (size_t)nxt.pm * tstep + (nxt.q > 0 ? (size_t)(nxt.q >> 1) * hstep : 0) : cA; const char* nB = has_next ? (const char*)g.Bt + (size_t)nxt.pn * tstep + (nxt.q > 0 ? (size_t)(nxt.q & 1) * hstep : 0) : cB;
        const bool fullu = cur.q < 0;
        for (int t = 0; t < nt; t += 2) {
            const bool last = (t == nt - 2);
            const char* a1 = cA + (size_t)(t + 1) * kstep;
            const char* a2 = last ? nA : cA + (size_t)(t + 2) * kstep; const char* b2 = last ? nB : cB + (size_t)(t + 2) * kstep;
            const char* a3 = a2 + kstep; const char* b3 = b2 + kstep;
            const size_t hs1 = fullu ? hstep : 0, hs2 = ((last && has_next) ? (nxt.q < 0) : fullu) ? hstep : 0;
            if (last && has_next) S.a_ready(nxt);
            PG8_LDB(B0, 0, 0); PG8_SCHED; PG8_LDA(At, 0, 0); PG8_STAGE(PG8_SA(1, 1), a1 + hs1, voffA);
            PG8_WAIT_L(8); PG8_BAR; PG8_WAIT_L(0); PG8_MMA(0, 0, At, B0); PG8_BAR; PG8_SCHED;
            PG8_LDB(B1, 0, 1); PG8_STAGE(PG8_SB(0, 0), b2, voffB);
            PG8_BAR; PG8_WAIT_L(0); if (fullu) PG8_MMA(0, 1, At, B1); PG8_BAR;
            PG8_LDA(At, 0, 1); PG8_STAGE(PG8_SA(0, 0), a2, voffA);
            PG8_BAR; PG8_WAIT_L(0); if (fullu) PG8_MMA(1, 0, At, B0); PG8_BAR; PG8_SCHED;
            PG8_STAGE(PG8_SB(0, 1), b2 + hs2, voffB);
            PG8_WAIT_V(6); PG8_BAR; if (fullu) PG8_MMA(1, 1, At, B1); PG8_BAR;
            PG8_LDB(B0, 1, 0); PG8_SCHED; PG8_LDA(At, 1, 0); PG8_STAGE(PG8_SA(0, 1), a2 + hs2, voffA);
            PG8_WAIT_L(8); PG8_BAR; PG8_WAIT_L(0); PG8_MMA(0, 0, At, B0); PG8_BAR; PG8_SCHED;
            PG8_LDB(B1, 1, 1); PG8_STAGE(PG8_SB(1, 0), b3, voffB);
            PG8_BAR; PG8_WAIT_L(0); if (fullu) PG8_MMA(0, 1, At, B1); PG8_BAR;
            PG8_LDA(At, 1, 1); PG8_STAGE(PG8_SA(1, 0), a3, voffA);
            PG8_BAR; PG8_WAIT_L(0); if (fullu) PG8_MMA(1, 0, At, B0); PG8_BAR; PG8_SCHED;
            PG8_STAGE(PG8_SB(1, 1), b3 + hs2, voffB);
            PG8_WAIT_V(6); PG8_BAR; if (fullu) PG8_MMA(1, 1, At, B1); PG8_BAR;
        }
        PG8_STAMP();
        if constexpr (!Epi::AFTER_DRAIN) { E(acc, aux, cur, wr, wc, fr, fq); S.done(cur); }
        PG8_STAMP();
        if (!has_next) break;
        E.pre(aux, nxt, wr, wc, fr, fq);
        if constexpr (Epi::INIT_ACC) E.init(acc, nxt, wr, wc, fr, fq);
        if constexpr (true) { asm volatile("" ::: "memory"); __builtin_amdgcn_sched_barrier(0); }
        if constexpr (!Epi::INIT_ACC) {
#pragma unroll
        for (int a = 0; a < 2; ++a)
#pragma unroll
            for (int b = 0; b < 2; ++b)
#pragma unroll
                for (int m = 0; m < 4; ++m)
#pragma unroll
                    for (int n = 0; n < 2; ++n) acc[a][b][m][n] = (f32x4){0.f, 0.f, 0.f, 0.f};
        }
        cur = nxt; cA = nA; cB = nB; ++ui;
    }
    PG8_WAIT_V(0);
    if (wr == 0) PG8_BAR;
    PG8_BAR;
    if constexpr (Epi::AFTER_DRAIN) { E.fused(acc, cur, wr, wc, fr, fq, lds, wid, lane); S.done(cur); }
    PG8_STAMP();
    if (STAMP && wid == 0) { stamps[lane] = lane < nts ? (((unsigned long long)(unsigned)ts_hi << 32) | (unsigned)ts_lo) : 0ull;
        if (lane == 62) stamps[62] = rt_entry; if (lane == 63) stamps[63] = (unsigned long long)wall_clock64(); }
#undef PG8_STAMP
#undef PG8_SA
#undef PG8_SB
#undef PG8_STAGE
#undef PG8_LDA
#undef PG8_LDB
#undef PG8_MMA
#undef PG8_WAIT_V
#undef PG8_WAIT_L
#undef PG8_BAR
#undef PG8_SCHED
}
}

using pg8::bf16_t;
#define LAS __attribute__((address_space(3)))
typedef float f4 __attribute__((ext_vector_type(4)));

constexpr int D = 1024, NBP = 8, LP = 2064, NSB = 128, LS = 8, NMETA = 16;
constexpr int T_P = NBP * LP, T = T_P + NSB * LS, MP = 17664;
constexpr int DI = 2048, CD = 3072, NH = 32, DSTATE = 128, DFF = 2816, NINP = 5376, NUG = 5632;
constexpr float EPS = 1e-5f;

constexpr size_t O0 = 0, O1 = O0 + (size_t)8 * 2048 * 1024, O2 = O1 + (size_t)128 * 8 * 1024, O3 = O2 + 8 * 2 * 1024, O4 = O3 + 8 * 3 * 3072,
                 O5 = O4 + (size_t)8 * 32 * 64 * 128, O6 = O5 + 2 * 8 * 2 * 2816, O7 = O6 + 128 * 2 * 1024, O8 = O7 + 128 * 3 * 3072,
                 O9 = O8 + (size_t)128 * 32 * 64 * 128, OEND = O9 + 2 * 128 * 2 * 2816;

constexpr size_t al256(size_t x) { return (x + 255) & ~(size_t)255; }
constexpr size_t W_SC_IN = 0, W_SC_OUT = W_SC_IN + (size_t)3072 * 1024 * 2, W_UG0 = W_SC_OUT + (size_t)1024 * 1024 * 2, W_UG1 = W_UG0 + (size_t)NUG * 1024 * 2,
                 W_DN0 = W_UG1 + (size_t)NUG * 1024 * 2, W_DN1 = W_DN0 + (size_t)1024 * DFF * 2, W_SSM_IN = W_DN1 + (size_t)1024 * DFF * 2,
                 W_SSM_OUT = W_SSM_IN + (size_t)NINP * 1024 * 2, W_X = W_SSM_OUT + (size_t)1024 * 2048 * 2, W_XB = W_X + (size_t)MP * 1024 * 4,
                 W_BIG = W_XB + (size_t)MP * 1024 * 2, W_ABUF = W_BIG + (size_t)MP * NUG * 2, W_DTRAW = W_ABUF + (size_t)MP * 3072 * 2,
                 W_DTS = W_DTRAW + (size_t)MP * 32 * 4, W_SS = W_DTS + (size_t)MP * 32 * 4, W_BAR = W_SS + (size_t)5 * MP * 4, W_ZERO = W_BAR + 16384, W_END = W_ZERO + 32768;

struct Params { const float* in[25]; float* out; unsigned char* ws; int ph_lo, ph_hi; };

__device__ __forceinline__ void unpack8(const uint4 v, float* f) {
    f[0] = __uint_as_float(v.x << 16); f[1] = __uint_as_float(v.x & 0xffff0000u); f[2] = __uint_as_float(v.y << 16); f[3] = __uint_as_float(v.y & 0xffff0000u);
    f[4] = __uint_as_float(v.z << 16); f[5] = __uint_as_float(v.z & 0xffff0000u); f[6] = __uint_as_float(v.w << 16); f[7] = __uint_as_float(v.w & 0xffff0000u);
}
__device__ __forceinline__ uint4 pack8(const float* f) {
    uint4 r; r.x = pg8::cvt_pk_bf16(f[0], f[1]); r.y = pg8::cvt_pk_bf16(f[2], f[3]); r.z = pg8::cvt_pk_bf16(f[4], f[5]); r.w = pg8::cvt_pk_bf16(f[6], f[7]); return r;
}
__device__ __forceinline__ void load8f(const float* q, float* f) { const f4 a = *(const f4*)q, b = *(const f4*)(q + 4); f[0] = a.x; f[1] = a.y; f[2] = a.z; f[3] = a.w; f[4] = b.x; f[5] = b.y; f[6] = b.z; f[7] = b.w; }
__device__ __forceinline__ void store8f(float* q, const float* f) { *(f4*)q = (f4){f[0], f[1], f[2], f[3]}; *(f4*)(q + 4) = (f4){f[4], f[5], f[6], f[7]}; }
__device__ __forceinline__ float silu_f(float x) { return x * __builtin_amdgcn_rcpf(1.0f + __expf(-x)); }
__device__ __forceinline__ void row_decode(int row, int& isP, int& b, int& t) {
    if (row < T_P) { isP = 1; b = row / LP; t = row - b * LP; } else { isP = 0; const int r = row - T_P; b = r >> 3; t = r & 7; }
}

struct EpiScale {
    static constexpr bool PERM = true, AFTER_DRAIN = false, INIT_ACC = false;
    bf16_t* O0; int ld0, ncol0; bf16_t* O1; int ld1, ncol1; float* DT; const float* ss;
    __device__ __forceinline__ void pre(float (&aux)[8], const pg8::Unit& u, int wr, int wc, int fr, int fq) const {
        const int row0 = u.pm * 256 + wr * 64 + fr;
#pragma unroll
        for (int ai = 0; ai < 2; ++ai)
#pragma unroll
            for (int m = 0; m < 4; ++m) aux[ai * 4 + m] = ss[row0 + ai * 128 + m * 16];
    }
    __device__ __forceinline__ void operator()(const pg8::f32x4 (&acc)[2][2][4][2], const float (&aux)[8], const pg8::Unit& u, int wr, int wc, int fr, int fq) const {
        const int row0 = u.pm * 256 + wr * 64 + fr; const int colt = u.pn * 256;
        bf16_t* base; int ld; bool isdt = false;
        if (colt < ncol0) { base = O0 + colt; ld = ld0; } else if (colt < ncol0 + ncol1) { base = O1 + (colt - ncol0); ld = ld1; } else { base = O0; ld = 0; isdt = true; }
        const int col0 = wc * 32 + 8 * fq;
#pragma unroll
        for (int ai = 0; ai < 2; ++ai)
#pragma unroll
            for (int m = 0; m < 4; ++m) {
                const int row = row0 + ai * 128 + m * 16;
                const float rs = __builtin_amdgcn_rsqf(aux[ai * 4 + m] * (1.0f / 1024.0f) + EPS);
                if (!isdt) {
                    bf16_t* rowp = base + (size_t)row * ld + col0;
#pragma unroll
                    for (int bj = 0; bj < 2; ++bj) {
                        const pg8::f32x4 v0 = acc[ai][bj][m][0] * rs, v1 = acc[ai][bj][m][1] * rs;
                        pg8::u32x4 w; w.x = pg8::cvt_pk_bf16(v0[0], v0[1]); w.y = pg8::cvt_pk_bf16(v0[2], v0[3]); w.z = pg8::cvt_pk_bf16(v1[0], v1[1]); w.w = pg8::cvt_pk_bf16(v1[2], v1[3]);
                        *(pg8::u32x4*)(rowp + bj * 128) = w;
                    }
                } else if (wc == 0) {
                    float* q = DT + (size_t)row * 32 + 8 * fq;
                    *(pg8::f32x4*)q = acc[ai][0][m][0] * rs; *(pg8::f32x4*)(q + 4) = acc[ai][0][m][1] * rs;
                }
            }
    }
};
template <int N> __device__ __forceinline__ float row_ror(float x) { return __int_as_float(__builtin_amdgcn_update_dpp(0, __float_as_int(x), 0x120 + N, 0xf, 0xf, false)); }
struct EpiSsm {
    static constexpr bool PERM = true, AFTER_DRAIN = false, INIT_ACC = false;
    bf16_t* Zo; bf16_t* RAW; bf16_t* XC; float* DTS; const float* ss; const float* cw; const float* cb; const float* dtb;
    __device__ __forceinline__ void pre(float (&aux)[8], const pg8::Unit& u, int wr, int wc, int fr, int fq) const {
        const int row0 = u.pm * 256 + wr * 64 + fr;
#pragma unroll
        for (int ai = 0; ai < 2; ++ai)
#pragma unroll
            for (int m = 0; m < 4; ++m) aux[ai * 4 + m] = ss[row0 + ai * 128 + m * 16];
    }
    __device__ __forceinline__ void operator()(const pg8::f32x4 (&acc)[2][2][4][2], const float (&aux)[8], const pg8::Unit& u, int wr, int wc, int fr, int fq) const {
        const int rowb = u.pm * 256 + wr * 64 + fr;
        pg8::u32x4 pk[2][2][4];
#pragma unroll
        for (int ai = 0; ai < 2; ++ai)
#pragma unroll
            for (int m = 0; m < 4; ++m) { const float rs = __builtin_amdgcn_rsqf(aux[ai * 4 + m] * (1.0f / 1024.0f) + EPS);
#pragma unroll
                for (int bj = 0; bj < 2; ++bj) { const pg8::f32x4 v0 = acc[ai][bj][m][0] * rs, v1 = acc[ai][bj][m][1] * rs;
                    pk[ai][bj][m].x = pg8::cvt_pk_bf16(v0[0], v0[1]); pk[ai][bj][m].y = pg8::cvt_pk_bf16(v0[2], v0[3]); pk[ai][bj][m].z = pg8::cvt_pk_bf16(v1[0], v1[1]); pk[ai][bj][m].w = pg8::cvt_pk_bf16(v1[2], v1[3]); }
                if (u.pn == 20 && wc == 0) {
                    const int row = rowb + ai * 128 + m * 16; float bb[8], v[8]; load8f(dtb + 8 * fq, bb);
#pragma unroll
                    for (int n = 0; n < 2; ++n)
#pragma unroll
                        for (int jj = 0; jj < 4; ++jj) { const float z = acc[ai][0][m][n][jj] * rs + bb[4 * n + jj]; v[4 * n + jj] = z > 20.f ? z : log1pf(__expf(z)); }
                    store8f(DTS + (size_t)row * 32 + 8 * fq, v);
                } }
        if (u.pn < 8) {
#pragma unroll
            for (int ai = 0; ai < 2; ++ai)
#pragma unroll
                for (int m = 0; m < 4; ++m)
#pragma unroll
                    for (int bj = 0; bj < 2; ++bj) *(pg8::u32x4*)(Zo + (size_t)(rowb + ai * 128 + m * 16) * 2048 + u.pn * 256 + bj * 128 + wc * 32 + 8 * fq) = pk[ai][bj][m];
        } else if (u.pn < 20) {
#pragma unroll
            for (int bj = 0; bj < 2; ++bj) {
                const int ch = (u.pn - 8) * 256 + bj * 128 + wc * 32 + 8 * fq;
                float w0[8], w1[8], w2[8], w3[8], bi[8]; load8f(cw + ch, w0); load8f(cw + 3072 + ch, w1); load8f(cw + 2 * 3072 + ch, w2); load8f(cw + 3 * 3072 + ch, w3); load8f(cb + ch, bi);
#pragma unroll
                for (int ai = 0; ai < 2; ++ai) {
                    float p1[8], p2[8], p3[8];
#pragma unroll
                    for (int i = 0; i < 8; ++i) { p1[i] = 0.f; p2[i] = 0.f; p3[i] = 0.f; }
#pragma unroll
                    for (int m = 0; m < 4; ++m) {
                        const int row = rowb + ai * 128 + m * 16; const pg8::u32x4 raw = pk[ai][bj][m];
                        float uu[8], s1[8], s2[8], s3[8]; unpack8(make_uint4(raw.x, raw.y, raw.z, raw.w), uu);
#pragma unroll
                        for (int i = 0; i < 8; ++i) { s1[i] = row_ror<1>(uu[i]); s2[i] = row_ror<2>(uu[i]); s3[i] = row_ror<3>(uu[i]); }
                        int isP, b, t; row_decode(row, isP, b, t); const int Lr = isP ? LP : LS;
                        const bool defer = (m == 0 && fr < 3) || t < 3;
                        const bool wantRaw = defer || ((row & 63) >= 61) || t >= Lr - 3;
                        if (wantRaw) *(pg8::u32x4*)(RAW + (size_t)row * 3072 + ch) = raw;
                        float o[8];
#pragma unroll
                        for (int i = 0; i < 8; ++i) { const float t1 = fr >= 1 ? s1[i] : p1[i], t2 = fr >= 2 ? s2[i] : p2[i], t3 = fr >= 3 ? s3[i] : p3[i];
                            o[i] = silu_f(bi[i] + w0[i] * t3 + w1[i] * t2 + w2[i] * t1 + w3[i] * uu[i]); p1[i] = s1[i]; p2[i] = s2[i]; p3[i] = s3[i]; }
                        if (!defer) *(uint4*)(XC + (size_t)row * 3072 + ch) = pack8(o);
                    }
                }
            }
        }
    }
};
struct EpiFfn {
    static constexpr bool PERM = true, AFTER_DRAIN = false, INIT_ACC = false;
    bf16_t* U; bf16_t* A2; const float* ss; PG8_LAS const unsigned char* cwl;
    __device__ __forceinline__ void pre(float (&aux)[8], const pg8::Unit& u, int wr, int wc, int fr, int fq) const {
        const int row0 = u.pm * 256 + wr * 64 + fr;
#pragma unroll
        for (int ai = 0; ai < 2; ++ai)
#pragma unroll
            for (int m = 0; m < 4; ++m) aux[ai * 4 + m] = ss[row0 + ai * 128 + m * 16];
    }
    __device__ __forceinline__ void operator()(const pg8::f32x4 (&acc)[2][2][4][2], const float (&aux)[8], const pg8::Unit& u, int wr, int wc, int fr, int fq) const {
        const int rowb = u.pm * 256 + wr * 64 + fr; const int ch = u.pn * 128 + wc * 32 + 8 * fq;
        float w0[8], w1[8], w2[8];
        { const pg8::u32x4 r0 = *(const PG8_LAS pg8::u32x4*)(cwl + (size_t)ch * 2), r1 = *(const PG8_LAS pg8::u32x4*)(cwl + (size_t)(DFF + ch) * 2), r2 = *(const PG8_LAS pg8::u32x4*)(cwl + (size_t)(2 * DFF + ch) * 2);
          unpack8(make_uint4(r0.x, r0.y, r0.z, r0.w), w0); unpack8(make_uint4(r1.x, r1.y, r1.z, r1.w), w1); unpack8(make_uint4(r2.x, r2.y, r2.z, r2.w), w2); }
#pragma unroll
        for (int ai = 0; ai < 2; ++ai) {
            float p1[8], p2[8];
#pragma unroll
            for (int i = 0; i < 8; ++i) { p1[i] = 0.f; p2[i] = 0.f; }
#pragma unroll
            for (int m = 0; m < 4; ++m) {
                const int row = rowb + ai * 128 + m * 16; const float rs = __builtin_amdgcn_rsqf(aux[ai * 4 + m] * (1.0f / 1024.0f) + EPS);
                float uu[8], gg[8], s1[8], s2[8];
#pragma unroll
                for (int n = 0; n < 2; ++n)
#pragma unroll
                    for (int jj = 0; jj < 4; ++jj) { uu[4 * n + jj] = acc[ai][0][m][n][jj] * rs; gg[4 * n + jj] = acc[ai][1][m][n][jj] * rs; }
#pragma unroll
                for (int i = 0; i < 8; ++i) { s1[i] = row_ror<1>(uu[i]); s2[i] = row_ror<2>(uu[i]); }
                int isP, b, t; row_decode(row, isP, b, t); const int Lr = isP ? LP : LS;
                const bool defer = (m == 0 && fr < 2) || t < 2;
                const bool wantU = defer || ((row & 63) >= 62) || t >= Lr - 2;
                if (wantU) *(uint4*)(U + (size_t)row * DFF + ch) = pack8(uu);
                float o[8];
#pragma unroll
                for (int i = 0; i < 8; ++i) { const float t1 = fr >= 1 ? s1[i] : p1[i], t2 = fr >= 2 ? s2[i] : p2[i]; o[i] = defer ? gg[i] : silu_f(w0[i] * t2 + w1[i] * t1 + w2[i] * uu[i]) * gg[i]; p1[i] = s1[i]; p2[i] = s2[i]; }
                *(uint4*)(A2 + (size_t)row * DFF + ch) = pack8(o);
            }
        }
    }
};
struct EpiResid {
    static constexpr bool PERM = true, AFTER_DRAIN = false, INIT_ACC = true;
    bf16_t* Xb; float* ssn;
    __device__ __forceinline__ void init(pg8::f32x4 (&acc)[2][2][4][2], const pg8::Unit& u, int wr, int wc, int fr, int fq) const {
        const bool full = u.q < 0;
        const int row0 = u.pm * 256 + (full ? 0 : (u.q >> 1) * 128) + wr * 64 + fr; const int col0 = u.pn * 256 + (full ? 0 : (u.q & 1) * 128) + wc * 32 + 8 * fq;
        pg8::u32x4 raw[2][4][2];
#pragma unroll
        for (int ai = 0; ai < 2; ++ai)
#pragma unroll
            for (int m = 0; m < 4; ++m)
#pragma unroll
                for (int bj = 0; bj < 2; ++bj) { raw[ai][m][bj] = (pg8::u32x4){0u, 0u, 0u, 0u}; if (full || (ai == 0 && bj == 0)) raw[ai][m][bj] = *(const pg8::u32x4*)(Xb + (size_t)(row0 + ai * 128 + m * 16) * 1024 + col0 + bj * 128); }
#pragma unroll
        for (int ai = 0; ai < 2; ++ai)
#pragma unroll
            for (int m = 0; m < 4; ++m)
#pragma unroll
                for (int bj = 0; bj < 2; ++bj) { const pg8::u32x4 v = raw[ai][m][bj];
                    acc[ai][bj][m][0] = (pg8::f32x4){__uint_as_float(v.x << 16), __uint_as_float(v.x & 0xffff0000u), __uint_as_float(v.y << 16), __uint_as_float(v.y & 0xffff0000u)};
                    acc[ai][bj][m][1] = (pg8::f32x4){__uint_as_float(v.z << 16), __uint_as_float(v.z & 0xffff0000u), __uint_as_float(v.w << 16), __uint_as_float(v.w & 0xffff0000u)}; }
    }
    __device__ __forceinline__ void pre(float (&aux)[8], const pg8::Unit&, int, int, int, int) const {
#pragma unroll
        for (int i = 0; i < 8; ++i) aux[i] = 0.f;
    }
    __device__ __forceinline__ void operator()(const pg8::f32x4 (&acc)[2][2][4][2], const float (&aux)[8], const pg8::Unit& u, int wr, int wc, int fr, int fq) const {
        const bool full = u.q < 0;
        const int row0 = u.pm * 256 + (full ? 0 : (u.q >> 1) * 128) + wr * 64 + fr; const int col0 = u.pn * 256 + (full ? 0 : (u.q & 1) * 128) + wc * 32 + 8 * fq;
#pragma unroll
        for (int ai = 0; ai < 2; ++ai) {
            if (ai == 1 && !full) break;
#pragma unroll
            for (int m = 0; m < 4; ++m) {
                const int row = row0 + ai * 128 + m * 16; float s = 0.f;
#pragma unroll
                for (int bj = 0; bj < 2; ++bj) {
                    if (bj == 1 && !full) break;
                    const pg8::f32x4 v0 = acc[ai][bj][m][0], v1 = acc[ai][bj][m][1];
                    pg8::u32x4 w; w.x = pg8::cvt_pk_bf16(v0[0], v0[1]); w.y = pg8::cvt_pk_bf16(v0[2], v0[3]); w.z = pg8::cvt_pk_bf16(v1[0], v1[1]); w.w = pg8::cvt_pk_bf16(v1[2], v1[3]);
                    *(pg8::u32x4*)(Xb + (size_t)row * 1024 + col0 + bj * 128) = w;
                    s += v0[0] * v0[0] + v0[1] * v0[1] + v0[2] * v0[2] + v0[3] * v0[3] + v1[0] * v1[0] + v1[1] * v1[1] + v1[2] * v1[2] + v1[3] * v1[3];
                }
                s += __shfl_xor(s, 16); s += __shfl_xor(s, 32);
                if (fq == 0) atomicAdd(ssn + row, s);
            }
        }
    }
};
template <class Epi, class Sched> __device__ __forceinline__ void run_gemm_s(PG8_LAS unsigned char* lds, const bf16_t* A, const bf16_t* Bt, int N, int K, const Epi& E) {
    pg8::Gemm g{A, Bt, MP, N, K}; Sched S; S.init(MP, N, (int)gridDim.x, (int)blockIdx.x);
    pg8::gemm_phase<Epi, Sched, false>(lds, g, S, E, nullptr);
}
template <class Epi> __device__ __forceinline__ void run_gemm(PG8_LAS unsigned char* lds, const bf16_t* A, const bf16_t* Bt, int N, int K, const Epi& E) {
    pg8::Gemm g{A, Bt, MP, N, K}; pg8::StaticOrder S; S.init(MP, N, (int)gridDim.x, (int)blockIdx.x);
    pg8::gemm_phase<Epi, pg8::StaticOrder, false>(lds, g, S, E, nullptr);
}

__device__ __forceinline__ void convert_tiles(const Params& p, float* tile  , int lo, int hi, int widx, int wcnt) {
    const int tid = threadIdx.x; unsigned char* ws = p.ws;
    constexpr int NJ = 10;
    const int jt[NJ + 1] = {0, 192, 256, 432, 608, 784, 1120, 1248, 1424, 1600, 1776};
    for (int gt = lo + widx; gt < hi; gt += wcnt) {
        int j = 0;
#pragma unroll
        for (int q = 1; q < NJ; ++q) if (gt >= jt[q]) j = q;
        const int lt = gt - jt[j];
        const float* src; const float* scale = nullptr; bf16_t* dst; int K = 1024, N, Npad; int ilv = -1;
        switch (j) {
            case 0: src = p.in[10]; scale = p.in[7]; dst = (bf16_t*)(ws + W_SC_IN); N = 3072; Npad = 3072; break;
            case 1: src = p.in[12]; dst = (bf16_t*)(ws + W_SC_OUT); N = 1024; Npad = 1024; break;
            case 2: src = p.in[21]; scale = p.in[8]; dst = (bf16_t*)(ws + W_UG0); N = DFF; Npad = DFF; ilv = 0; break;
            case 3: src = p.in[22]; scale = p.in[8]; dst = (bf16_t*)(ws + W_UG0); N = DFF; Npad = DFF; ilv = 128; break;
            case 4: src = p.in[24]; dst = (bf16_t*)(ws + W_DN0); K = DFF; N = 1024; Npad = 1024; break;
            case 5: src = p.in[13]; scale = p.in[7] + 1024; dst = (bf16_t*)(ws + W_SSM_IN); N = 5152; Npad = NINP; break;
            case 6: src = p.in[20]; dst = (bf16_t*)(ws + W_SSM_OUT); K = 2048; N = 1024; Npad = 1024; break;
            case 7: src = p.in[21] + (size_t)1024 * DFF; scale = p.in[8] + 1024; dst = (bf16_t*)(ws + W_UG1); N = DFF; Npad = DFF; ilv = 0; break;
            case 8: src = p.in[22] + (size_t)1024 * DFF; scale = p.in[8] + 1024; dst = (bf16_t*)(ws + W_UG1); N = DFF; Npad = DFF; ilv = 128; break;
            default: src = p.in[24] + (size_t)DFF * 1024; dst = (bf16_t*)(ws + W_DN1); K = DFF; N = 1024; Npad = 1024; break;
        }
        const int ntn = Npad / 256; const int k0 = (lt / ntn) * 64, n0 = (lt % ntn) * 256;
        const int nn = tid & 255, kh = tid >> 8;
        float v[32];
#pragma unroll
        for (int i = 0; i < 32; ++i) v[i] = (n0 + nn < N) ? src[(size_t)(k0 + i * 2 + kh) * N + n0 + nn] : 0.f;
        if (scale) {
#pragma unroll
            for (int i = 0; i < 32; ++i) v[i] *= scale[k0 + i * 2 + kh];
        }
        __syncthreads();
#pragma unroll
        for (int i = 0; i < 32; ++i) tile[(i * 2 + kh) * 257 + nn] = v[i];
        __syncthreads();
#pragma unroll
        for (int i = 0; i < 16; ++i) {
            const int n2 = i * 16 + (tid >> 5), kk = (tid & 31) * 2;
            const int nc_ = n0 + n2; const int drow = ilv < 0 ? nc_ : ((nc_ >> 7) * 256 + (nc_ & 127) + ilv);
            *(unsigned*)(dst + (size_t)drow * K + k0 + kk) = pg8::cvt_pk_bf16(tile[kk * 257 + n2], tile[(kk + 1) * 257 + n2]);
        }
    }
    __syncthreads();
}
__device__ __forceinline__ void phase_prep(const Params& p, float* tile) {
    const int tid = threadIdx.x; unsigned char* ws = p.ws;
    convert_tiles(p, tile, 0, 192, (int)blockIdx.x, (int)gridDim.x);
    for (int q = blockIdx.x * 512 + tid; q < 8192; q += gridDim.x * 512) ((float*)(ws + W_ZERO))[q] = 0.f;
    bf16_t* Xb = (bf16_t*)(ws + W_XB); float* SS = (float*)(ws + W_SS);
    const int lane = tid & 63, wv = tid >> 6; constexpr int NR = 3; const int rstride = gridDim.x * 8;
    for (int row0 = blockIdx.x * 8 + wv; row0 < MP; row0 += NR * rstride) {
        f4 v[NR][4];
#pragma unroll
        for (int u = 0; u < NR; ++u) { const int row = row0 + u * rstride; const float* src = nullptr;
            if (row < T_P) { const int b = row / LP, t = row - b * LP; src = t < NMETA ? p.in[6] + (size_t)t * 1024 : p.in[0] + ((size_t)b * 2048 + (t - NMETA)) * 1024; }
            else if (row < T) src = p.in[1] + (size_t)(row - T_P) * 1024;
#pragma unroll
            for (int i = 0; i < 4; ++i) { v[u][i] = (f4){0.f, 0.f, 0.f, 0.f}; if (src) v[u][i] = *(const f4*)(src + i * 256 + lane * 4); } }
#pragma unroll
        for (int u = 0; u < NR; ++u) { const int row = row0 + u * rstride; float s = 0.f;
#pragma unroll
            for (int i = 0; i < 4; ++i) { const f4 x = v[u][i];
                if (row < MP) { uint2 w; w.x = pg8::cvt_pk_bf16(x.x, x.y); w.y = pg8::cvt_pk_bf16(x.z, x.w); *(uint2*)(Xb + (size_t)row * 1024 + i * 256 + lane * 4) = w; }
                s += x.x * x.x + x.y * x.y + x.z * x.z + x.w * x.w; }
#pragma unroll
            for (int o = 32; o >= 1; o >>= 1) s += __shfl_xor(s, o);
            if (lane == 0 && row < MP) { SS[row] = s; SS[MP + row] = 0.f; SS[2 * MP + row] = 0.f; SS[3 * MP + row] = 0.f; SS[4 * MP + row] = 0.f; }
        }
    }
}
__device__ __forceinline__ void phase_sc_conv(const Params& p) {
    const bf16_t* BCX = (const bf16_t*)(p.ws + W_BIG); bf16_t* A1 = (bf16_t*)(p.ws + W_ABUF);
    const float* cw = p.in[11]; const float* cache = p.in[2];
    constexpr int R = 8, NIT = (T / R) * 128; const int stride = gridDim.x * 512;
    for (int idx = blockIdx.x * 512 + threadIdx.x; idx < NIT; idx += stride) {
        const int r0 = (idx >> 7) * R, c = (idx & 127) * 8; int isP, b, t0; row_decode(r0, isP, b, t0);
        uint4 rc[R + 2], rx[R + 2], rb[R];
#pragma unroll
        for (int i = 0; i < R + 2; ++i) { const int r = (t0 == 0 && i < 2) ? r0 : r0 + i - 2; const bf16_t* q = BCX + (size_t)r * 3072 + c; rc[i] = *(const uint4*)(q + 1024); rx[i] = *(const uint4*)(q + 2048); }
#pragma unroll
        for (int i = 0; i < R; ++i) rb[i] = *(const uint4*)(BCX + (size_t)(r0 + i) * 3072 + c);
        float w[3][8];
#pragma unroll
        for (int k = 0; k < 3; ++k) load8f(cw + k * 1024 + c, w[k]);
        float cx[R + 2][8];
#pragma unroll
        for (int i = 0; i < R + 2; ++i) { float xv[8]; unpack8(rc[i], cx[i]); unpack8(rx[i], xv);
#pragma unroll
            for (int j = 0; j < 8; ++j) cx[i][j] *= xv[j]; }
        if (t0 == 0) {
#pragma unroll
            for (int i = 0; i < 2; ++i) { if (!isP) load8f(cache + ((size_t)b * 2 + i) * 1024 + c, cx[i]); else {
#pragma unroll
                for (int j = 0; j < 8; ++j) cx[i][j] = 0.f; } }
        }
#pragma unroll
        for (int i = 0; i < R; ++i) { float bg[8], o[8]; unpack8(rb[i], bg);
#pragma unroll
            for (int j = 0; j < 8; ++j) o[j] = bg[j] * (w[0][j] * cx[i][j] + w[1][j] * cx[i + 1][j] + w[2][j] * cx[i + 2][j]);
            *(uint4*)(A1 + (size_t)(r0 + i) * 1024 + c) = pack8(o); }
        const int Lr = isP ? LP : LS;
        if (t0 + R == Lr) { float* o = p.out + (isP ? O2 : O6) + (size_t)b * 2 * 1024 + c; store8f(o, cx[R]); store8f(o + 1024, cx[R + 1]); }
    }
}
__device__ __forceinline__ void phase_ffn_fix(const Params& p, int li) {
    const bf16_t* U = (const bf16_t*)(p.ws + W_BIG); bf16_t* A2 = (bf16_t*)(p.ws + W_ABUF);
    const float* cw = p.in[23] + (size_t)li * 3 * DFF; const float* cache = p.in[5] + (size_t)li * NSB * 2 * DFF;
    constexpr int NB64 = MP / 64, NR = NB64 * 2 + 12 + 224, NIT = NR * 352; const int stride = gridDim.x * 512;
    for (int idx = blockIdx.x * 512 + threadIdx.x; idx < NIT; idx += stride) {
        const int ri = idx / 352, c = (idx - ri * 352) * 8; int row;
        if (ri < NB64 * 2) row = 64 * (ri >> 1) + (ri & 1);
        else if (ri < NB64 * 2 + 12) { const int k = ri - NB64 * 2, q = k >> 1, bb = q < 3 ? q + 1 : q + 2; row = bb * LP + (k & 1); }
        else { const int k = ri - NB64 * 2 - 12, sp = k >> 1, s = sp + sp / 7 + 1; row = T_P + 8 * s + (k & 1); }
        if (row >= T) continue;
        int isP, b, t; row_decode(row, isP, b, t);
        float acc[8];
#pragma unroll
        for (int j = 0; j < 8; ++j) acc[j] = 0.f;
#pragma unroll
        for (int k = 0; k < 3; ++k) {
            const int tp = t - 2 + k; float uu[8];
            if (tp >= 0) unpack8(*(const uint4*)(U + (size_t)(row - 2 + k) * DFF + c), uu);
            else if (!isP) load8f(cache + ((size_t)b * 2 + (2 + tp)) * DFF + c, uu);
            else {
#pragma unroll
                for (int j = 0; j < 8; ++j) uu[j] = 0.f; }
            float w[8]; load8f(cw + k * DFF + c, w);
#pragma unroll
            for (int j = 0; j < 8; ++j) acc[j] += w[j] * uu[j];
        }
        float g[8]; unpack8(*(const uint4*)(A2 + (size_t)row * DFF + c), g);
#pragma unroll
        for (int j = 0; j < 8; ++j) acc[j] = silu_f(acc[j]) * g[j];
        *(uint4*)(A2 + (size_t)row * DFF + c) = pack8(acc);
    }
    for (int idx = blockIdx.x * 512 + threadIdx.x; idx < (NBP + NSB) * 2 * 352; idx += stride) {
        const int sj = idx / 352, c = (idx - sj * 352) * 8, sq = sj >> 1, j = sj & 1;
        const int isP = sq < NBP, b = isP ? sq : sq - NBP; const int row = isP ? b * LP + LP - 2 + j : T_P + b * LS + LS - 2 + j;
        float uu[8]; unpack8(*(const uint4*)(U + (size_t)row * DFF + c), uu);
        store8f(p.out + (isP ? O5 + ((size_t)(li * NBP + b) * 2 + j) * DFF : O9 + ((size_t)(li * NSB + b) * 2 + j) * DFF) + c, uu);
    }
}
__device__ __forceinline__ void phase_ssm_fix(const Params& p) {
    const bf16_t* RAW = (const bf16_t*)(p.ws + W_BIG) + (size_t)MP * 2048; bf16_t* XC = (bf16_t*)(p.ws + W_ABUF);
    const float* cw = p.in[14]; const float* cb = p.in[15]; const float* cache = p.in[3];
    constexpr int NB64 = MP / 64, NR = NB64 * 3 + 18 + 336, NIT = NR * 384; const int stride = gridDim.x * 512;
    for (int idx = blockIdx.x * 512 + threadIdx.x; idx < NIT; idx += stride) {
        const int ri = idx / 384, c = (idx - ri * 384) * 8; int row;
        if (ri < NB64 * 3) { const int k = ri / 3; row = 64 * k + (ri - 3 * k); }
        else if (ri < NB64 * 3 + 18) { const int k = ri - NB64 * 3, q = k / 3, bb = q < 3 ? q + 1 : q + 2; row = bb * LP + (k - 3 * q); }
        else { const int k = ri - NB64 * 3 - 18, sp = k / 3, s = sp + sp / 7 + 1; row = T_P + 8 * s + (k - 3 * sp); }
        if (row >= T) continue;
        int isP, b, t; row_decode(row, isP, b, t);
        float acc[8]; load8f(cb + c, acc);
#pragma unroll
        for (int k = 0; k < 4; ++k) {
            const int tp = t - 3 + k; float uu[8];
            if (tp >= 0) unpack8(*(const uint4*)(RAW + (size_t)(row - 3 + k) * 3072 + c), uu);
            else if (!isP) load8f(cache + ((size_t)b * 3 + (3 + tp)) * 3072 + c, uu);
            else {
#pragma unroll
                for (int j = 0; j < 8; ++j) uu[j] = 0.f; }
            float w[8]; load8f(cw + k * 3072 + c, w);
#pragma unroll
            for (int j = 0; j < 8; ++j) acc[j] += w[j] * uu[j];
        }
#pragma unroll
        for (int j = 0; j < 8; ++j) acc[j] = silu_f(acc[j]);
        *(uint4*)(XC + (size_t)row * 3072 + c) = pack8(acc);
    }
    for (int idx = blockIdx.x * 512 + threadIdx.x; idx < (NBP + NSB) * 3 * 384; idx += stride) {
        const int sj = idx / 384, c = (idx - sj * 384) * 8, sq = sj / 3, j = sj - 3 * sq;
        const int isP = sq < NBP, b = isP ? sq : sq - NBP; const int row = isP ? b * LP + LP - 3 + j : T_P + b * LS + LS - 3 + j;
        float uu[8]; unpack8(*(const uint4*)(RAW + (size_t)row * 3072 + c), uu);
        store8f(p.out + (isP ? O3 : O7) + ((size_t)b * 3 + j) * 3072 + c, uu);
    }
}
typedef float f32x16 __attribute__((ext_vector_type(16)));
typedef short s16x4 __attribute__((ext_vector_type(4)));
typedef unsigned u32x2 __attribute__((ext_vector_type(2)));
constexpr int SI_C = 0, SI_B = 32768, SI_X = 65536, SI_M = 98304, SI_S = 131072, SI_CUM = 147456, SI_DT = SI_CUM + 512, SI_WG = SI_DT + 512, SI_AD = SI_WG + 512, SSD_LDS = SI_AD + 256;
__device__ __forceinline__ unsigned off_b(unsigned row, unsigned ch) { return 256u * row + 16u * (ch ^ (((row & 3u) << 2) | ((row >> 2) & 3u))); }
__device__ __forceinline__ pg8::bf16x8 rd_row(LAS unsigned char* img, unsigned row, unsigned ks, unsigned hh) { return *(const LAS pg8::bf16x8*)(img + off_b(row, 2u * ks + hh)); }
__device__ __forceinline__ pg8::bf16x8 rd_tr(LAS unsigned char* img, unsigned lane, unsigned c, unsigned ks) {
    const unsigned h = lane >> 5, blk = (lane >> 4) & 1u, q = (lane & 15u) >> 2, pp = lane & 3u;
    const s16x4 lo = __builtin_amdgcn_ds_read_tr16_b64_v4i16((LAS s16x4*)(img + off_b(16u * ks + 8u * h + q, 4u * c + 2u * blk + (pp >> 1)) + 8u * (pp & 1u)));
    const s16x4 hi = __builtin_amdgcn_ds_read_tr16_b64_v4i16((LAS s16x4*)(img + off_b(16u * ks + 8u * h + 4u + q, 4u * c + 2u * blk + (pp >> 1)) + 8u * (pp & 1u)));
    return (pg8::bf16x8){lo[0], lo[1], lo[2], lo[3], hi[0], hi[1], hi[2], hi[3]};
}
#define SSD_BAR() do { asm volatile("s_waitcnt lgkmcnt(0)" ::: "memory"); __builtin_amdgcn_s_barrier(); asm volatile("" ::: "memory"); } while (0)
__device__ __forceinline__ void phase_ssd(const Params& p, LAS unsigned char* lds) {
    const bf16_t* XC = (const bf16_t*)(p.ws + W_ABUF); const bf16_t* Z = (const bf16_t*)(p.ws + W_BIG); bf16_t* Y = (bf16_t*)(p.ws + W_BIG) + (size_t)MP * 2048;
    const float* DTS = (const float*)(p.ws + W_DTS);
    const int tid = threadIdx.x, lane = tid & 63, w = __builtin_amdgcn_readfirstlane(tid >> 6), hh = lane >> 5, l31 = lane & 31;
    const int lt = w >> 1, pt = w & 1;
    LAS float* cumL = (LAS float*)(lds + SI_CUM); LAS float* dtL = (LAS float*)(lds + SI_DT); LAS float* wgL = (LAS float*)(lds + SI_WG); LAS float* aL = (LAS float*)(lds + SI_AD); LAS float* dL = aL + 32;
    if (tid < 32) { aL[tid] = -__expf(p.in[17][tid]); dL[tid] = p.in[18][tid]; }
    __syncthreads();
    const int lrow = lt * 32 + l31;
    constexpr int NITEMS = 256 + NSB * NH;
    int item = blockIdx.x; if (item >= NITEMS) return;
    int isP, b, h, g, row0, L, nch; float a, dsk; size_t sbase;
#define SSD_DECODE(it) do { if ((it) < 256) { isP = 1; const int pr_ = ((it) & 7) * 4 + ((it) >> 6); b = pr_ >> 2; h = (pr_ & 3) * 8 + (((it) >> 3) & 7); }     \
         else { isP = 0; b = ((it) - 256) >> 5; h = ((it) - 256) & 31; } \
        g = h >> 3; row0 = isP ? b * LP : T_P + b * LS; L = isP ? LP : LS; nch = (L + 127) >> 7; a = aL[h]; dsk = dL[h]; \
        sbase = ((size_t)(b * NH + h) * 64 + (pt * 32 + l31)) * 128 + lt * 32 + 4 * hh; } while (0)
    pg8::u32x4 rC[4], rB[4], rX[2]; float dtr[2]; f4 s0r[4];
#define SSD_LOAD(row0_, L_, h_, g_, cc) do { const int t0_ = (cc) * 128; const int rmax_ = (L_) - t0_ - 1;     \
            _Pragma("unroll") for (int i = 0; i < 4; ++i) { int r_ = (tid >> 4) + 32 * i; r_ = r_ < rmax_ ? r_ : rmax_; const int ch_ = tid & 15; \
                const bf16_t* q_ = XC + (size_t)((row0_) + t0_ + r_) * 3072 + 2048 + (g_) * 128 + ch_ * 8; rB[i] = *(const pg8::u32x4*)q_; rC[i] = *(const pg8::u32x4*)(q_ + 512); } \
            _Pragma("unroll") for (int i = 0; i < 2; ++i) { int r_ = (tid >> 3) + 64 * i; r_ = r_ < rmax_ ? r_ : rmax_; const int ch_ = tid & 7; \
                rX[i] = *(const pg8::u32x4*)(XC + (size_t)((row0_) + t0_ + r_) * 3072 + (h_) * 64 + ch_ * 8); } \
            { int r0_ = 2 * lane, r1_ = 2 * lane + 1; r0_ = r0_ < rmax_ ? r0_ : rmax_; r1_ = r1_ < rmax_ ? r1_ : rmax_; \
              dtr[0] = DTS[(size_t)((row0_) + t0_ + r0_) * 32 + (h_)]; dtr[1] = DTS[(size_t)((row0_) + t0_ + r1_) * 32 + (h_)]; } } while (0)
#define SSD_LOAD_S0(ptr_) do { _Pragma("unroll") for (int q = 0; q < 4; ++q) s0r[q] = *(const f4*)((ptr_) + 8 * q); } while (0)
    const float* zpage = (const float*)(p.ws + W_ZERO) + ((pt * 32 + l31) * 128 + lt * 32 + 4 * hh);
#define SSD_WRITE_S() do { _Pragma("unroll") for (int q = 0; q < 4; ++q) { u32x2 wv; wv.x = pg8::cvt_pk_bf16(accS[4 * q], accS[4 * q + 1]); wv.y = pg8::cvt_pk_bf16(accS[4 * q + 2], accS[4 * q + 3]); \
            *(LAS u32x2*)(lds + SI_S + 8192u * pt + (sW ^ (64u * lt + 16u * q))) = wv; } } while (0)
    unsigned rowL = off_b(l31, hh);
    unsigned mW = off_b(lrow, 0) + 8u * hh;
    unsigned sW = off_b(l31, 0) + 8u * hh;
    unsigned trX0, trX1, trB0, trB1;
    { const unsigned h_ = lane >> 5, blk = (lane >> 4) & 1u, q_ = (lane & 15u) >> 2, pp = lane & 3u;
      trX0 = off_b(8u * h_ + q_, 4u * pt + 2u * blk + (pp >> 1)) + 8u * (pp & 1u); trX1 = off_b(8u * h_ + 4u + q_, 4u * pt + 2u * blk + (pp >> 1)) + 8u * (pp & 1u);
      trB0 = off_b(8u * h_ + q_, 4u * lt + 2u * blk + (pp >> 1)) + 8u * (pp & 1u); trB1 = off_b(8u * h_ + 4u + q_, 4u * lt + 2u * blk + (pp >> 1)) + 8u * (pp & 1u); }
    unsigned stg = off_b((unsigned)tid >> 4, (unsigned)tid & 15u), stgX = off_b((unsigned)tid >> 3, (unsigned)tid & 7u);
#define RROW(img, tile, ks) (*(const LAS pg8::bf16x8*)(lds + (img) + 8192u * (tile) + (rowL ^ (32u * (ks)))))
#define RTR(img, b0, b1, ks) ({ const s16x4 lo_ = __builtin_amdgcn_ds_read_tr16_b64_v4i16((LAS s16x4*)(lds + (img) + (b0) + 4096u * (ks))); const s16x4 hi_ = __builtin_amdgcn_ds_read_tr16_b64_v4i16((LAS s16x4*)(lds + (img) + (b1) + 4096u * (ks))); \
        (pg8::bf16x8){lo_[0], lo_[1], lo_[2], lo_[3], hi_[0], hi_[1], hi_[2], hi_[3]}; })
    SSD_DECODE(item);
    dtr[0] = 0.f; dtr[1] = 0.f;
    SSD_LOAD(row0, L, h, g, 0); SSD_LOAD_S0(isP ? zpage : p.in[4] + sbase);
    f32x16 accS;
    int c = 0;
    for (;;) {
        asm volatile("" : "+v"(rowL), "+v"(mW), "+v"(sW), "+v"(trX0), "+v"(trX1), "+v"(trB0), "+v"(trB1), "+v"(stg), "+v"(stgX));
        if (c == 0) {
#pragma unroll
            for (int q = 0; q < 4; ++q) { accS[4 * q] = s0r[q].x; accS[4 * q + 1] = s0r[q].y; accS[4 * q + 2] = s0r[q].z; accS[4 * q + 3] = s0r[q].w; }
            SSD_WRITE_S();
        }
        const int t0 = c * 128; const int nv = (L - t0) < 128 ? (L - t0) : 128; const int ksmax = (nv + 15) >> 4;
#pragma unroll
        for (int i = 0; i < 4; ++i) { const bool ok_ = (tid >> 4) + 32 * i < nv; const pg8::u32x4 z4 = (pg8::u32x4){0u, 0u, 0u, 0u}; *(LAS pg8::u32x4*)(lds + SI_C + stg + 8192u * i) = ok_ ? rC[i] : z4; *(LAS pg8::u32x4*)(lds + SI_B + stg + 8192u * i) = ok_ ? rB[i] : z4; }
#pragma unroll
        for (int i = 0; i < 2; ++i) { const bool ok_ = (tid >> 3) + 64 * i < nv; *(LAS pg8::u32x4*)(lds + SI_X + stgX + 16384u * i) = ok_ ? rX[i] : (pg8::u32x4){0u, 0u, 0u, 0u}; }
        if (w == 0) {
            const float dt0 = (2 * lane < nv) ? dtr[0] : 0.f, dt1 = (2 * lane + 1 < nv) ? dtr[1] : 0.f;
            const float d0 = dt0 * a, d1 = dt1 * a, ps = d0 + d1; float incl = ps;
#pragma unroll
            for (int o = 1; o < 64; o <<= 1) { const float v = __shfl_up(incl, o); if (lane >= o) incl += v; }
            const float c0 = incl - ps + d0, c1 = incl, clast = __shfl(incl, 63);
            cumL[2 * lane] = c0; cumL[2 * lane + 1] = c1; dtL[2 * lane] = dt0; dtL[2 * lane + 1] = dt1;
            wgL[2 * lane] = dt0 * __expf(clast - c0); wgL[2 * lane + 1] = dt1 * __expf(clast - c1);
        }
        u32x2 zr[4];
        { const int tl = (t0 + lrow) < L ? (t0 + lrow) : (L - 1);
#pragma unroll
          for (int q = 0; q < 4; ++q) zr[q] = *(const u32x2*)(Z + (size_t)(row0 + tl) * 2048 + h * 64 + pt * 32 + 8 * q + 4 * hh); }
        const bool last_chunk = (c + 1 == nch); const int nitem = item + (int)gridDim.x; const bool has_next_item = nitem < NITEMS;
        const int cur_row0 = row0, cur_L = L, cur_h = h, cur_isP = isP; const float cur_dsk = dsk; const size_t cur_sbase = sbase;
        __builtin_amdgcn_sched_barrier(0);
        if (last_chunk && has_next_item) SSD_DECODE(nitem);
        SSD_LOAD(row0, L, h, g, last_chunk ? 0 : c + 1);
        SSD_LOAD_S0((last_chunk && has_next_item && !isP) ? p.in[4] + sbase : zpage);
        SSD_BAR();
        const bool act = lt * 32 < nv;
        f32x16 accY;
#pragma unroll
        for (int r = 0; r < 16; ++r) accY[r] = 0.f;
        float cl = 0.f;
        if (act) {
#pragma unroll
            for (int ks = 0; ks < 8; ++ks) { const pg8::bf16x8 Sf = RROW(SI_S, pt, ks), Cf = RROW(SI_C, lt, ks); accY = __builtin_amdgcn_mfma_f32_32x32x16_bf16(Sf, Cf, accY, 0, 0, 0); }
            cl = cumL[lrow]; const float el = __expf(cl);
#pragma unroll
            for (int r = 0; r < 16; ++r) accY[r] *= el;
#pragma unroll
            for (int si = 0; si < 2; ++si) {
                const int st = 2 * pt + si;
                if (st <= lt && st * 32 < nv) {
                    f32x16 accG;
#pragma unroll
                    for (int r = 0; r < 16; ++r) accG[r] = 0.f;
#pragma unroll
                    for (int ks = 0; ks < 8; ++ks) { const pg8::bf16x8 Bf = RROW(SI_B, st, ks), Cf = RROW(SI_C, lt, ks); accG = __builtin_amdgcn_mfma_f32_32x32x16_bf16(Bf, Cf, accG, 0, 0, 0); }
#pragma unroll
                    for (int q = 0; q < 4; ++q) {
                        const int s4 = st * 32 + 8 * q + 4 * hh; const f4 cs = *(const LAS f4*)(cumL + s4), ds = *(const LAS f4*)(dtL + s4); float mv[4];
#pragma unroll
                        for (int e = 0; e < 4; ++e) mv[e] = (s4 + e <= lrow) ? accG[4 * q + e] * __expf(cl - cs[e]) * ds[e] : 0.f;
                        u32x2 wv; wv.x = pg8::cvt_pk_bf16(mv[0], mv[1]); wv.y = pg8::cvt_pk_bf16(mv[2], mv[3]);
                        *(LAS u32x2*)(lds + SI_M + (mW ^ (64u * st + 16u * q))) = wv;
                    }
                }
            }
        }
        SSD_BAR();
        if (act) {
            const int kl = 2 * (lt + 1) < ksmax ? 2 * (lt + 1) : ksmax;
#define SSD_C2(NK) do { _Pragma("unroll") for (int ks = 0; ks < (NK); ++ks) { const pg8::bf16x8 Xf = RTR(SI_X, trX0, trX1, ks); const pg8::bf16x8 Mf = RROW(SI_M, lt, ks); accY = __builtin_amdgcn_mfma_f32_32x32x16_bf16(Xf, Mf, accY, 0, 0, 0); } } while (0)
            if (nv == 128) { if (lt == 0) SSD_C2(2); else if (lt == 1) SSD_C2(4); else if (lt == 2) SSD_C2(6); else SSD_C2(8); }
            else for (int ks = 0; ks < kl; ++ks) { const pg8::bf16x8 Xf = RTR(SI_X, trX0, trX1, ks); const pg8::bf16x8 Mf = RROW(SI_M, lt, ks); accY = __builtin_amdgcn_mfma_f32_32x32x16_bf16(Xf, Mf, accY, 0, 0, 0); }
#undef SSD_C2
            if (t0 + lrow < cur_L) {
#pragma unroll
                for (int q = 0; q < 4; ++q) {
                    const unsigned p4 = pt * 32 + 8 * q + 4 * hh; const u32x2 xr = *(const LAS u32x2*)(lds + SI_X + (mW ^ (64u * pt + 16u * q)));
                    const float x0 = __uint_as_float(xr.x << 16), x1 = __uint_as_float(xr.x & 0xffff0000u), x2 = __uint_as_float(xr.y << 16), x3 = __uint_as_float(xr.y & 0xffff0000u);
                    const float z0 = __uint_as_float(zr[q].x << 16), z1 = __uint_as_float(zr[q].x & 0xffff0000u), z2 = __uint_as_float(zr[q].y << 16), z3 = __uint_as_float(zr[q].y & 0xffff0000u);
                    u32x2 wv; wv.x = pg8::cvt_pk_bf16((accY[4 * q] + cur_dsk * x0) * silu_f(z0), (accY[4 * q + 1] + cur_dsk * x1) * silu_f(z1));
                    wv.y = pg8::cvt_pk_bf16((accY[4 * q + 2] + cur_dsk * x2) * silu_f(z2), (accY[4 * q + 3] + cur_dsk * x3) * silu_f(z3));
                    *(u32x2*)(Y + (size_t)(cur_row0 + t0 + lrow) * 2048 + cur_h * 64 + p4) = wv;
                }
            }
        }
        {
            const float el = __expf(cumL[127]);
#pragma unroll
            for (int r = 0; r < 16; ++r) accS[r] *= el;
#define SSD_D_STEP(ks) do { \
                const pg8::bf16x8 Bf = RTR(SI_B, trB0, trB1, ks); const pg8::bf16x8 Xr = RTR(SI_X, trX0, trX1, ks); \
                const f4 w0 = *(const LAS f4*)(wgL + 16 * (ks) + 8 * hh), w1 = *(const LAS f4*)(wgL + 16 * (ks) + 8 * hh + 4); \
                float xf[8]; \
                _Pragma("unroll") for (int j = 0; j < 8; ++j) xf[j] = __uint_as_float(((unsigned)(unsigned short)Xr[j]) << 16); \
                pg8::u32x4 pk; pk.x = pg8::cvt_pk_bf16(xf[0] * w0.x, xf[1] * w0.y); pk.y = pg8::cvt_pk_bf16(xf[2] * w0.z, xf[3] * w0.w); pk.z = pg8::cvt_pk_bf16(xf[4] * w1.x, xf[5] * w1.y); pk.w = pg8::cvt_pk_bf16(xf[6] * w1.z, xf[7] * w1.w); \
                pg8::bf16x8 Xw; __builtin_memcpy(&Xw, &pk, 16); \
                accS = __builtin_amdgcn_mfma_f32_32x32x16_bf16(Bf, Xw, accS, 0, 0, 0); } while (0)
            if (ksmax == 8) {
#pragma unroll
                for (int ks = 0; ks < 8; ++ks) SSD_D_STEP(ks);
            } else for (int ks = 0; ks < ksmax; ++ks) SSD_D_STEP(ks);
#undef SSD_D_STEP
        }
        SSD_BAR();
        if (!last_chunk) { SSD_WRITE_S(); ++c; }
        else {
            float* so = p.out + (cur_isP ? O4 : O8) + cur_sbase;
#pragma unroll
            for (int q = 0; q < 4; ++q) *(f4*)(so + 8 * q) = (f4){accS[4 * q], accS[4 * q + 1], accS[4 * q + 2], accS[4 * q + 3]};
            if (!has_next_item) break;
            item = nitem; c = 0;
        }
    }
    asm volatile("s_waitcnt vmcnt(0)" ::: "memory");
    __syncthreads();
#undef SSD_LOAD
#undef RROW
#undef RTR
#undef SSD_LOAD_S0
#undef SSD_DECODE
#undef SSD_WRITE_S
}
__device__ __forceinline__ void phase_gnorm(const Params& p) {
    bf16_t* Y = (bf16_t*)(p.ws + W_BIG) + (size_t)MP * 2048; const float* nw = p.in[19];
    const int lane = threadIdx.x & 63, wv = threadIdx.x >> 6; constexpr int NR = 3; const int rstride = gridDim.x * 8;
    float w[4][8];
#pragma unroll
    for (int i = 0; i < 4; ++i) load8f(nw + lane * 32 + i * 8, w[i]);
    for (int row0 = blockIdx.x * 8 + wv; row0 < T; row0 += NR * rstride) {
        uint4 raw[NR][4];
#pragma unroll
        for (int u = 0; u < NR; ++u) { const int row = row0 + u * rstride < T ? row0 + u * rstride : row0;
#pragma unroll
            for (int i = 0; i < 4; ++i) raw[u][i] = *(const uint4*)(Y + (size_t)row * 2048 + lane * 32 + i * 8); }
#pragma unroll
        for (int u = 0; u < NR; ++u) { const int row = row0 + u * rstride; float v[4][8]; float s = 0.f;
#pragma unroll
            for (int i = 0; i < 4; ++i) { unpack8(raw[u][i], v[i]);
#pragma unroll
                for (int j = 0; j < 8; ++j) s += v[i][j] * v[i][j]; }
            s += __shfl_xor(s, 1); s += __shfl_xor(s, 2); s += __shfl_xor(s, 4); s += __shfl_xor(s, 8);
            const float rs = __builtin_amdgcn_rsqf(s * (1.0f / 512.0f) + EPS);
            if (row < T) {
#pragma unroll
                for (int i = 0; i < 4; ++i) {
#pragma unroll
                    for (int j = 0; j < 8; ++j) v[i][j] *= rs * w[i][j];
                    *(uint4*)(Y + (size_t)row * 2048 + lane * 32 + i * 8) = pack8(v[i]); } }
        }
    }
}
__device__ __forceinline__ void phase_final(const Params& p) {
    const bf16_t* Xb = (const bf16_t*)(p.ws + W_XB); const float* SS4 = (const float*)(p.ws + W_SS) + 4 * (size_t)MP; const float* nw = p.in[9];
    const int lane = threadIdx.x & 63, wv = threadIdx.x >> 6; constexpr int NR = 3; const int rstride = gridDim.x * 8;
    float w[2][8];
#pragma unroll
    for (int i = 0; i < 2; ++i) load8f(nw + i * 512 + lane * 8, w[i]);
    for (int row0 = blockIdx.x * 8 + wv; row0 < T; row0 += NR * rstride) {
        uint4 raw[NR][2]; float ssv[NR];
#pragma unroll
        for (int u = 0; u < NR; ++u) { const int row = row0 + u * rstride < T ? row0 + u * rstride : row0; ssv[u] = SS4[row];
#pragma unroll
            for (int i = 0; i < 2; ++i) raw[u][i] = *(const uint4*)(Xb + (size_t)row * 1024 + i * 512 + lane * 8); }
#pragma unroll
        for (int u = 0; u < NR; ++u) { const int row = row0 + u * rstride;
            if (row >= T) continue;
            int isP, b, t; row_decode(row, isP, b, t);
            if (isP && t < NMETA) continue;
            float* o = isP ? p.out + O0 + ((size_t)b * 2048 + (t - NMETA)) * 1024 : p.out + O1 + (size_t)(row - T_P) * 1024;
            const float rs = __builtin_amdgcn_rsqf(ssv[u] * (1.0f / 1024.0f) + EPS);
#pragma unroll
            for (int i = 0; i < 2; ++i) { float v[8]; unpack8(raw[u][i], v);
#pragma unroll
                for (int j = 0; j < 8; ++j) v[j] *= rs * w[i][j];
                store8f(o + i * 512 + lane * 8, v); }
        }
    }
}

#define XB_TMO      128
#define XB_XCNT(j)  (256  + 64 * (j))
#define XB_XSUB(j)  (1280 + 64 * (j))
#define XB_XGEN(j)  (2304 + 64 * (j))
#define XB_TOP      3328
#define XB_TOPGEN   3392
#define XCD_BAR_WORDS 3456
#define XB_SPIN_CAP (1u << 18)
#define LAS __attribute__((address_space(3)))

__device__ __forceinline__ unsigned xb_ld(unsigned* p)              { return __hip_atomic_load(p, __ATOMIC_RELAXED, __HIP_MEMORY_SCOPE_AGENT); }
__device__ __forceinline__ unsigned xb_add(unsigned* p, unsigned v) { return __hip_atomic_fetch_add(p, v, __ATOMIC_RELAXED, __HIP_MEMORY_SCOPE_AGENT); }
__device__ __forceinline__ unsigned xb_xcc_id() { return (unsigned)__builtin_amdgcn_s_getreg((3 << 11) | 20) & 0xFu; }
#define XB_SPIN(cond, bar) do { unsigned _sp = 0; while (cond) { __builtin_amdgcn_s_sleep(1); \
    if ((++_sp & 255u) == 0u) { if (xb_ld(&(bar)[XB_TMO])) break; if (_sp > XB_SPIN_CAP) { atomicAdd(&(bar)[XB_TMO], 1u); break; } } } } while (0)

struct XcdBarrier {
    unsigned* bar; unsigned x;
    volatile LAS unsigned* st;
};

__device__ __forceinline__ XcdBarrier xcd_barrier_post(unsigned* bar, volatile LAS unsigned* st) {
    XcdBarrier b; b.bar = bar; b.x = xb_xcc_id(); b.st = st;
    if (threadIdx.x == 0) (void)xb_add(&bar[XB_XCNT(b.x)], 1u);
    return b;
}
__device__ __forceinline__ void xcd_barrier_complete(unsigned* bar, unsigned x, unsigned& nloc, unsigned& nx) {
    const unsigned G = gridDim.x * gridDim.y * gridDim.z;
    unsigned sum, cnt, mine, sp = 0u;
    for (;;) {
        sum = 0u; cnt = 0u; mine = 0u;
#pragma unroll
        for (unsigned j = 0; j < 16; ++j) { const unsigned c = xb_ld(&bar[XB_XCNT(j)]); sum += c; cnt += (c > 0u) ? 1u : 0u; mine = (j == x) ? c : mine; }
        if (sum == G) break;
        __builtin_amdgcn_s_sleep(1);
        if ((++sp & 255u) == 0u) { if (xb_ld(&bar[XB_TMO])) break; if (sp > XB_SPIN_CAP) { atomicAdd(&bar[XB_TMO], 1u); break; } }
    }
    nloc = mine > 0u ? mine : 1u; nx = cnt > 0u ? cnt : 1u;
}

__device__ __forceinline__ void xcd_barrier(const XcdBarrier& b) {
    asm volatile("s_waitcnt vmcnt(0)" ::: "memory");
    __syncthreads();
    if (threadIdx.x == 0) {
        unsigned* bar = b.bar;
        __builtin_amdgcn_s_waitcnt(0);
        unsigned nloc = b.st[0], nx = b.st[1];
        if (nloc == 0u) { xcd_barrier_complete(bar, b.x, nloc, nx); b.st[0] = nloc; b.st[1] = nx; }
        const unsigned old = xb_add(&bar[XB_XSUB(b.x)], 1u);
        const unsigned gen = old / nloc;
        if (old + 1u == (gen + 1u) * nloc) {
            __builtin_amdgcn_fence(__ATOMIC_RELEASE, "agent");
            asm volatile("s_waitcnt vmcnt(0)" ::: "memory");
            const unsigned og = xb_add(&bar[XB_TOP], 1u);
            const unsigned tg = og / nx;
            if (og + 1u == (tg + 1u) * nx) xb_add(&bar[XB_TOPGEN], 1u);
            else XB_SPIN(xb_ld(&bar[XB_TOPGEN]) == tg, bar);
            __builtin_amdgcn_fence(__ATOMIC_ACQUIRE, "agent");
            xb_add(&bar[XB_XGEN(b.x)], 1u);
            asm volatile("s_waitcnt vmcnt(0)" ::: "memory");
        } else {
            XB_SPIN(xb_ld(&bar[XB_XGEN(b.x)]) == gen, bar);
            __builtin_amdgcn_fence(__ATOMIC_ACQUIRE, "agent");
            asm volatile("s_waitcnt vmcnt(0)" ::: "memory");
        }
    }
    __syncthreads();
}


constexpr int NPHASE = 16, LDS_BYTES = SSD_LDS + 16;
__global__ void __launch_bounds__(512) fwd_megakernel(Params p) {
    extern __shared__ __attribute__((aligned(16))) unsigned char shm[];
    cg::grid_group grid = cg::this_grid();
    unsigned char* ws = p.ws;
    volatile LAS unsigned* xst = (volatile LAS unsigned*)((LAS unsigned char*)shm + (LDS_BYTES - 16));
    if (threadIdx.x == 0) { xst[0] = 0u; xst[1] = 0u; }
    __syncthreads();
    const XcdBarrier xb = xcd_barrier_post((unsigned*)(ws + W_BAR), xst);
    if (p.ph_hi > NPHASE) grid.sync();
    bf16_t* XB = (bf16_t*)(ws + W_XB); bf16_t* BIG = (bf16_t*)(ws + W_BIG); bf16_t* ABUF = (bf16_t*)(ws + W_ABUF); float* SS = (float*)(ws + W_SS);
#define PHASE(n, ...) if (p.ph_lo <= (n) && (n) < p.ph_hi) { __VA_ARGS__; if ((n) + 1 < p.ph_hi) xcd_barrier(xb); }
#define GEMM_S(n, WOFF, NN, LD0, NC0, O1P, LD1, NC1, SSI, ...) PHASE(n, { EpiScale E; E.O0 = BIG; E.ld0 = LD0; E.ncol0 = NC0; E.O1 = O1P; E.ld1 = LD1; E.ncol1 = NC1; E.DT = (float*)(ws + W_DTRAW); E.ss = SS + (size_t)(SSI) * MP; \
        run_gemm((PG8_LAS unsigned char*)shm, XB, (const bf16_t*)(ws + WOFF), NN, 1024, E); __VA_ARGS__; })
#define GEMM_R(n, AP, WOFF, KK, SSI, ...) PHASE(n, { EpiResid E; E.Xb = XB; E.ssn = SS + (size_t)(SSI) * MP; \
        run_gemm_s<EpiResid, pg8::TailOrder>((PG8_LAS unsigned char*)shm, AP, (const bf16_t*)(ws + WOFF), 1024, KK, E); __VA_ARGS__; })
    PHASE(0, phase_prep(p, (float*)shm))
    GEMM_S(1, W_SC_IN, 3072, 3072, 3072, BIG, 0, 0, 0, if (blockIdx.x >= 60 && gridDim.x > 60) convert_tiles(p, (float*)shm, 192, 608, (int)blockIdx.x - 60, (int)gridDim.x - 60))
    PHASE(2, phase_sc_conv(p))
    GEMM_R(3, ABUF, W_SC_OUT, 1024, 1, if (blockIdx.x >= 80 && gridDim.x > 80) convert_tiles(p, (float*)shm, 608, 784, (int)blockIdx.x - 80, (int)gridDim.x - 80))
    PHASE(4, { { const float* cwg_ = p.in[23]; PG8_LAS unsigned* dst_ = (PG8_LAS unsigned*)((PG8_LAS unsigned char*)shm + 131072); for (int q_ = threadIdx.x; q_ < 3 * DFF / 2; q_ += 512) dst_[q_] = pg8::cvt_pk_bf16(cwg_[2 * q_], cwg_[2 * q_ + 1]); __syncthreads(); }
        EpiFfn E; E.U = BIG; E.A2 = ABUF; E.ss = SS + (size_t)1 * MP; E.cwl = (PG8_LAS const unsigned char*)shm + 131072; run_gemm((PG8_LAS unsigned char*)shm, XB, (const bf16_t*)(ws + W_UG0), NUG, 1024, E); })
    PHASE(5, phase_ffn_fix(p, 0))
    GEMM_R(6, ABUF, W_DN0, DFF, 2, if (blockIdx.x >= 80 && gridDim.x > 80) convert_tiles(p, (float*)shm, 784, 1248, (int)blockIdx.x - 80, (int)gridDim.x - 80))
    PHASE(7, { EpiSsm E; E.Zo = BIG; E.RAW = BIG + (size_t)MP * 2048; E.XC = ABUF; E.DTS = (float*)(ws + W_DTS); E.ss = SS + (size_t)2 * MP; E.cw = p.in[14]; E.cb = p.in[15]; E.dtb = p.in[16]; run_gemm((PG8_LAS unsigned char*)shm, XB, (const bf16_t*)(ws + W_SSM_IN), NINP, 1024, E); })
    PHASE(8, phase_ssm_fix(p))
    PHASE(9, phase_ssd(p, (LAS unsigned char*)shm))
    PHASE(10, phase_gnorm(p))
    GEMM_R(11, BIG + (size_t)MP * 2048, W_SSM_OUT, 2048, 3, if (blockIdx.x >= 80 && gridDim.x > 80) convert_tiles(p, (float*)shm, 1248, 1776, (int)blockIdx.x - 80, (int)gridDim.x - 80))
    PHASE(12, { { const float* cwg_ = p.in[23] + (size_t)3 * DFF; PG8_LAS unsigned* dst_ = (PG8_LAS unsigned*)((PG8_LAS unsigned char*)shm + 131072); for (int q_ = threadIdx.x; q_ < 3 * DFF / 2; q_ += 512) dst_[q_] = pg8::cvt_pk_bf16(cwg_[2 * q_], cwg_[2 * q_ + 1]); __syncthreads(); }
        EpiFfn E; E.U = BIG; E.A2 = ABUF; E.ss = SS + (size_t)3 * MP; E.cwl = (PG8_LAS const unsigned char*)shm + 131072; run_gemm((PG8_LAS unsigned char*)shm, XB, (const bf16_t*)(ws + W_UG1), NUG, 1024, E); })
    PHASE(13, phase_ffn_fix(p, 1))
    GEMM_R(14, ABUF, W_DN1, DFF, 4)
    PHASE(15, phase_final(p))
}

extern "C" void kernel_launch(void* const* d_in, const int* in_sizes, int n_in, void* d_out, int out_size, void* d_ws, size_t ws_size, hipStream_t stream) {
    static int grid_blocks = 0;
    if (grid_blocks == 0) {
        if (n_in != 25 || (size_t)out_size != OEND || ws_size < W_END) { fprintf(stderr, "kernel_launch: unexpected shapes: n_in %d out %d ws %zu (need %zu)\n", n_in, out_size, ws_size, (size_t)W_END); grid_blocks = -1; return; }
        int dev = 0, cus = 0, per_cu = 0;
        hipGetDevice(&dev); hipDeviceGetAttribute(&cus, hipDeviceAttributeMultiprocessorCount, dev);
        if (hipFuncSetAttribute((const void*)fwd_megakernel, hipFuncAttributeMaxDynamicSharedMemorySize, LDS_BYTES) != hipSuccess) { fprintf(stderr, "kernel_launch: hipFuncSetAttribute failed\n"); grid_blocks = -1; return; }
        if (hipOccupancyMaxActiveBlocksPerMultiprocessor(&per_cu, (const void*)fwd_megakernel, 512, LDS_BYTES) != hipSuccess || per_cu < 1) { fprintf(stderr, "kernel_launch: occupancy query gave %d\n", per_cu); per_cu = 1; }
        (void)hipGetLastError();
        grid_blocks = cus * 1;
    }
    if (grid_blocks < 0) return;
    if (hipMemsetAsync((unsigned char*)d_ws + W_BAR, 0, 16384, stream) != hipSuccess) { fprintf(stderr, "kernel_launch: memset of barrier words failed\n"); return; }
    Params p{};
    for (int i = 0; i < 25; ++i) p.in[i] = (const float*)d_in[i];
    p.out = (float*)d_out; p.ws = (unsigned char*)d_ws;
#ifdef MULTI_LAUNCH
    for (int ph = 0; ph < NPHASE; ++ph) { p.ph_lo = ph; p.ph_hi = ph + 1; hipLaunchKernelGGL(fwd_megakernel, dim3(grid_blocks), dim3(512), LDS_BYTES, stream, p); }
#else
    p.ph_lo = 0; p.ph_hi = NPHASE;
    void* args[] = {&p};
    hipError_t e = hipLaunchCooperativeKernel((const void*)fwd_megakernel, dim3(grid_blocks), dim3(512), args, LDS_BYTES, stream);
    if (e != hipSuccess) fprintf(stderr, "cooperative launch failed: %s (grid %d)\n", hipGetErrorString(e), grid_blocks);
#endif
}
```

```cpp
#include <hip/hip_runtime.h>
#include <hip/hip_cooperative_groups.h>
#include <cstdio>
namespace cg = cooperative_groups;
namespace pg8 {
#define PG8_LAS __attribute__((address_space(3)))
typedef unsigned short bf16_t;
typedef short bf16x8 __attribute__((ext_vector_type(8)));
typedef float f32x4 __attribute__((ext_vector_type(4)));
typedef unsigned u32x4 __attribute__((ext_vector_type(4)));
constexpr int BM = 256, BK = 64, HALF = 128, HTB = HALF * BK * 2  , STAGE_BYTES = 8 * HTB, NXCD = 8, WGM = 4;

__host__ __device__ __forceinline__ int lds_byte(int r, int c) { const int st = (r >> 4) * 2 + (c >> 5), rr = r & 15, cc = c & 31, ob = rr * 64 + cc * 2; return st * 1024 + (ob ^ (((ob >> 9) & 1) << 5)); }
__host__ __device__ __forceinline__ void stage_rc(int b, int& R, int& C) { const int st = b / 1024, sb = b % 1024, swz = sb ^ (((sb >> 9) & 1) << 5); R = (st >> 1) * 16 + swz / 64; C = (st & 1) * 32 + (swz % 64) / 2; }
__host__ __device__ __forceinline__ int perm32(int rho) { const int n = rho >> 4, i = rho & 15; return 8 * (i >> 2) + 4 * n + (i & 3); }

struct Unit { int pm, pn, q; };
struct Gemm { const bf16_t* A; const bf16_t* Bt; int M, N, K; };

struct StaticOrder {
    int nM, nN, nwg, G, c;
    __host__ __device__ void init(int M, int N, int G_, int c_) { nM = M / BM; nN = N / BM; nwg = nM * nN; G = G_; c = c_; }
    __host__ __device__ void map(int L, Unit& u) const {
        int wgid = L; { const int q = nwg / NXCD, r = nwg % NXCD, xcd = wgid % NXCD, off = wgid / NXCD; wgid = (xcd < r ? xcd * (q + 1) : r * (q + 1) + (xcd - r) * q) + off; }
        const int nig = WGM * nN, gid = wgid / nig, fm = gid * WGM, gsz = (nM - fm) < WGM ? (nM - fm) : WGM;
        u.pm = fm + ((wgid % nig) % gsz); u.pn = (wgid % nig) / gsz; u.q = -1;
    }
    __host__ __device__ bool next(int i, Unit& u) const {
        const long L = (long)i * G + c; if (L >= nwg) return false;
        map((int)L, u); return true;
    }
    __device__ __forceinline__ void a_ready(const Unit&) const {}
    __device__ __forceinline__ void done(const Unit&) const {}
};
struct TailOrder : StaticOrder {
    __device__ bool split() const { return nwg > G && nwg <= 2 * G && 4 * (nwg - G) <= G; }
    __device__ bool next(int i, Unit& u) const {
        if (!split()) return StaticOrder::next(i, u);
        if (i == 0) { map(c, u); return true; }
        const int nt4 = 4 * (nwg - G);
        if (i == 1 && c < nt4) {
            int unit, q;
            if ((nt4 & 15) == 0) { const int xcd = c & 7, slot = c >> 3, pair = xcd * (nt4 >> 4) + (slot >> 1); unit = pair >> 1; q = ((pair & 1) << 1) | (slot & 1); }
            else { unit = c >> 2; q = c & 3; }
            map(G + unit, u); u.q = q; return true;
        }
        return false;
    }
};

__device__ __forceinline__ unsigned cvt_pk_bf16(float lo, float hi) { unsigned r; asm volatile("v_cvt_pk_bf16_f32 %0, %1, %2" : "=v"(r) : "v"(lo), "v"(hi)); return r; }
typedef float f32x2 __attribute__((ext_vector_type(2)));
template <class Epi, class Sched, bool STAMP = false>
__device__ __forceinline__ void gemm_phase(PG8_LAS unsigned char* lds, const Gemm g, const Sched& S, const Epi& E, unsigned long long* stamps) {
    const int tid = threadIdx.x, wid = __builtin_amdgcn_readfirstlane(tid >> 6), lane = tid & 63, wr = wid >> 2, wc = wid & 3, fr = lane & 15, fq = lane >> 4;
    const int K = g.K, nt = K / BK;
    int ts_lo = 0, ts_hi = 0, nts = 0; const unsigned long long rt_entry = STAMP ? (unsigned long long)wall_clock64() : 0ull;
#define PG8_STAMP() do { if (STAMP && wid == 0 && nts < 64) { const unsigned long long _c = (unsigned long long)clock64(); \
        ts_lo = (lane == nts) ? (int)(unsigned)_c : ts_lo; ts_hi = (lane == nts) ? (int)(unsigned)(_c >> 32) : ts_hi; ++nts; } } while (0)
    PG8_STAMP();
    unsigned voffA[2], voffB[2];
#pragma unroll
    for (int i = 0; i < 2; ++i) { int R, C; stage_rc(tid * 16 + i * 8192, R, C); const int Rb = Epi::PERM ? ((R & ~31) + perm32(R & 31)) : R;
        voffA[i] = (unsigned)(R * K + C) * 2u; voffB[i] = (unsigned)(Rb * K + C) * 2u; }
    const size_t kstep = (size_t)(BK * 2);
    const size_t hstep = (size_t)HALF * K * 2;
    const size_t tstep = 2 * hstep;
    const unsigned ldsw = (unsigned)wid * 1024u;
    const int aoff = lds_byte(wr * 64 + fr, fq * 8), boff = lds_byte(wc * 32 + fr, fq * 8);
#define PG8_SA(b, h) (((b) * 2 + (h)) * HTB)
#define PG8_SB(b, h) ((4 + (b) * 2 + (h)) * HTB)
#define PG8_STAGE(bufoff, gbase, voff) do { _Pragma("unroll") for (int _i = 0; _i < 2; ++_i) \
        __builtin_amdgcn_global_load_lds((const unsigned*)((const char*)(gbase) + (voff)[_i]), (PG8_LAS unsigned*)(lds + (bufoff) + ldsw + _i * 8192), 16, 0, 0); } while (0)
#define PG8_LDA(dst, b, h) do { _Pragma("unroll") for (int m = 0; m < 4; ++m) _Pragma("unroll") for (int k = 0; k < 2; ++k) dst[m][k] = *(const PG8_LAS bf16x8*)(lds + PG8_SA(b, h) + aoff + m * 2048 + k * 1024); } while (0)
#define PG8_LDB(dst, b, h) do { _Pragma("unroll") for (int n = 0; n < 2; ++n) _Pragma("unroll") for (int k = 0; k < 2; ++k) dst[n][k] = *(const PG8_LAS bf16x8*)(lds + PG8_SB(b, h) + boff + n * 2048 + k * 1024); } while (0)
#define PG8_MMA(ai, bj, At, Bt) do { __builtin_amdgcn_s_setprio(1); _Pragma("unroll") for (int m = 0; m < 4; ++m) _Pragma("unroll") for (int n = 0; n < 2; ++n) _Pragma("unroll") for (int k = 0; k < 2; ++k) \
        acc[ai][bj][m][n] = __builtin_amdgcn_mfma_f32_16x16x32_bf16(Bt[n][k], At[m][k], acc[ai][bj][m][n], 0, 0, 0); __builtin_amdgcn_s_setprio(0); } while (0)
#define PG8_WAIT_V(n) asm volatile("s_waitcnt vmcnt(" #n ")" ::: "memory")
#define PG8_WAIT_L(n) asm volatile("s_waitcnt lgkmcnt(" #n ")" ::: "memory")
#define PG8_BAR __builtin_amdgcn_s_barrier()
#define PG8_SCHED __builtin_amdgcn_sched_barrier(0)
    Unit cur, nxt; int ui = 0;
    if (!S.next(0, cur)) return;
    f32x4 acc[2][2][4][2];
    float aux[8];
    E.pre(aux, cur, wr, wc, fr, fq);
    if constexpr (Epi::INIT_ACC) E.init(acc, cur, wr, wc, fr, fq);
    if constexpr (true) { asm volatile("" ::: "memory"); __builtin_amdgcn_sched_barrier(0); }
    if constexpr (!Epi::INIT_ACC) {
#pragma unroll
    for (int a = 0; a < 2; ++a)
#pragma unroll
        for (int b = 0; b < 2; ++b)
#pragma unroll
            for (int m = 0; m < 4; ++m)
#pragma unroll
                for (int n = 0; n < 2; ++n) acc[a][b][m][n] = (f32x4){0.f, 0.f, 0.f, 0.f};
    }
    bf16x8 At[4][2], B0[2][2], B1[2][2];
    const char* cA = (const char*)g.A + (size_t)cur.pm * tstep + (cur.q > 0 ? (size_t)(cur.q >> 1) * hstep : 0); const char* cB = (const char*)g.Bt + (size_t)cur.pn * tstep + (cur.q > 0 ? (size_t)(cur.q & 1) * hstep : 0);
    S.a_ready(cur);
    const size_t hs0 = cur.q < 0 ? hstep : 0;
    PG8_STAGE(PG8_SB(0, 0), cB, voffB); PG8_STAGE(PG8_SA(0, 0), cA, voffA); PG8_STAGE(PG8_SB(0, 1), cB + hs0, voffB); PG8_STAGE(PG8_SA(0, 1), cA + hs0, voffA);
    if (wr == 1) PG8_BAR;
    PG8_WAIT_V(4); PG8_BAR;
    PG8_STAGE(PG8_SB(1, 0), cB + kstep, voffB); PG8_STAGE(PG8_SA(1, 0), cA + kstep, voffA); PG8_STAGE(PG8_SB(1, 1), cB + hs0 + kstep, voffB);
    PG8_WAIT_V(6); PG8_BAR;
    PG8_STAMP();
    for (;;) {
        const bool has_next = S.next(ui + 1, nxt);
        const char* nA = has_next ? (const char*)g.A + (size_t)nxt.pm * tstep + (nxt.q > 0 ? (size_t)(nxt.q >> 1) * hstep : 0) : cA; const char* nB = has_next ? (const char*)g.Bt + (size_t)nxt.pn * tstep + (nxt.q > 0 ? (size_t)(nxt.q & 1) * hstep : 0) : cB;
        const bool fullu = cur.q < 0;
        for (int t = 0; t < nt; t += 2) {
            const bool last = (t == nt - 2);
            const char* a1 = cA + (size_t)(t + 1) * kstep;
            const char* a2 = last ? nA : cA + (size_t)(t + 2) * kstep; const char* b2 = last ? nB : cB + (size_t)(t + 2) * kstep;
            const char* a3 = a2 + kstep; const char* b3 = b2 + kstep;
            const size_t hs1 = fullu ? hstep : 0, hs2 = ((last && has_next) ? (nxt.q < 0) : fullu) ? hstep : 0;
            if (last && has_next) S.a_ready(nxt);
            PG8_LDB(B0, 0, 0); PG8_SCHED; PG8_LDA(At, 0, 0); PG8_STAGE(PG8_SA(1, 1), a1 + hs1, voffA);
            PG8_WAIT_L(8); PG8_BAR; PG8_WAIT_L(0); PG8_MMA(0, 0, At, B0); PG8_BAR; PG8_SCHED;
            PG8_LDB(B1, 0, 1); PG8_STAGE(PG8_SB(0, 0), b2, voffB);
            PG8_BAR; PG8_WAIT_L(0); if (fullu) PG8_MMA(0, 1, At, B1); PG8_BAR;
            PG8_LDA(At, 0, 1); PG8_STAGE(PG8_SA(0, 0), a2, voffA);
            PG8_BAR; PG8_WAIT_L(0); if (fullu) PG8_MMA(1, 0, At, B0); PG8_BAR; PG8_SCHED;
            PG8_STAGE(PG8_SB(0, 1), b2 + hs2, voffB);
            PG8_WAIT_V(6); PG8_BAR; if (fullu) PG8_MMA(1, 1, At, B1); PG8_BAR;
            PG8_LDB(B0, 1, 0); PG8_SCHED; PG8_LDA(At, 1, 0); PG8_STAGE(PG8_SA(0, 1), a2 + hs2, voffA);
            PG8_WAIT_L(8); PG8_BAR; PG8_WAIT_L(0); PG8_MMA(0, 0, At, B0); PG8_BAR; PG8_SCHED;
            PG8_LDB(B1, 1, 1); PG8_STAGE(PG8_SB(1, 0), b3, voffB);
            PG8_BAR; PG8_WAIT_L(0); if (fullu) PG8_MMA(0, 1, At, B1); PG8_BAR;
            PG8_LDA(At, 1, 1); PG8_STAGE(PG8_SA(1, 0), a3, voffA);
            PG8_BAR; PG8_WAIT_L(0); if (fullu) PG8_MMA(1, 0, At, B0); PG8_BAR; PG8_SCHED;
            PG8_STAGE(PG8_SB(1, 1), b3 + hs2, voffB);
            PG8_WAIT_V(6); PG8_BAR; if (fullu) PG8_MMA(1, 1, At, B1); PG8_BAR;
        }
        PG8_STAMP();
        if constexpr (!Epi::AFTER_DRAIN) { E(acc, aux, cur, wr, wc, fr, fq); S.done(cur); }
        PG8_STAMP();
        if (!has_next) break;
        E.pre(aux, nxt, wr, wc, fr, fq);
        if constexpr (Epi::INIT_ACC) E.init(acc, nxt, wr, wc, fr, fq);
        if constexpr (true) { asm volatile("" ::: "memory"); __builtin_amdgcn_sched_barrier(0); }
        if constexpr (!Epi::INIT_ACC) {
#pragma unroll
        for (int a = 0; a < 2; ++a)
#pragma unroll
            for (int b = 0; b < 2; ++b)
#pragma unroll
                for (int m = 0; m < 4; ++m)
#pragma unroll
                    for (int n = 0; n < 2; ++n) acc[a][b][m][n] = (f32x4){0.f, 0.f, 0.f, 0.f};
        }
        cur = nxt; cA = nA; cB = nB; ++ui;
    }
    PG8_WAIT_V(0);
    if (wr == 0) PG8_BAR;
    PG8_BAR;
    if constexpr (Epi::AFTER_DRAIN) { E.fused(acc, cur, wr, wc, fr, fq, lds, wid, lane); S.done(cur); }
    PG8_STAMP();
    if (STAMP && wid == 0) { stamps[lane] = lane < nts ? (((unsigned long long)(unsigned)ts_hi << 32) | (unsigned)ts_lo) : 0ull;
        if (lane == 62) stamps[62] = rt_entry; if (lane == 63) stamps[63] = (unsigned long long)wall_clock64(); }
#undef PG8_STAMP
#undef PG8_SA
#undef PG8_SB
#undef PG8_STAGE
#undef PG8_LDA
#undef PG8_LDB
#undef PG8_MMA
#undef PG8_WAIT_V
#undef PG8_WAIT_L
#undef PG8_BAR
#undef PG8_SCHED
}
}

using pg8::bf16_t;
#define LAS __attribute__((address_space(3)))
typedef float f4 __attribute__((ext_vector_type(4)));

constexpr int D = 1024, NBP = 8, LP = 2064, NSB = 128, LS = 8, NMETA = 16;
constexpr int T_P = NBP * LP, T = T_P + NSB * LS, MP = 17664;
constexpr int DI = 2048, CD = 3072, NH = 32, DSTATE = 128, DFF = 2816, NINP = 5376, NUG = 5632;
constexpr float EPS = 1e-5f;

constexpr size_t O0 = 0, O1 = O0 + (size_t)8 * 2048 * 1024, O2 = O1 + (size_t)128 * 8 * 1024, O3 = O2 + 8 * 2 * 1024, O4 = O3 + 8 * 3 * 3072,
                 O5 = O4 + (size_t)8 * 32 * 64 * 128, O6 = O5 + 2 * 8 * 2 * 2816, O7 = O6 + 128 * 2 * 1024, O8 = O7 + 128 * 3 * 3072,
                 O9 = O8 + (size_t)128 * 32 * 64 * 128, OEND = O9 + 2 * 128 * 2 * 2816;

constexpr size_t al256(size_t x) { return (x + 255) & ~(size_t)255; }
constexpr size_t W_SC_IN = 0, W_SC_OUT = W_SC_IN + (size_t)3072 * 1024 * 2, W_UG0 = W_SC_OUT + (size_t)1024 * 1024 * 2, W_UG1 = W_UG0 + (size_t)NUG * 1024 * 2,
                 W_DN0 = W_UG1 + (size_t)NUG * 1024 * 2, W_DN1 = W_DN0 + (size_t)1024 * DFF * 2, W_SSM_IN = W_DN1 + (size_t)1024 * DFF * 2,
                 W_SSM_OUT = W_SSM_IN + (size_t)NINP * 1024 * 2, W_X = W_SSM_OUT + (size_t)1024 * 2048 * 2, W_XB = W_X + (size_t)MP * 1024 * 4,
                 W_BIG = W_XB + (size_t)MP * 1024 * 2, W_ABUF = W_BIG + (size_t)MP * NUG * 2, W_DTRAW = W_ABUF + (size_t)MP * 3072 * 2,
                 W_DTS = W_DTRAW + (size_t)MP * 32 * 4, W_SS = W_DTS + (size_t)MP * 32 * 4, W_BAR = W_SS + (size_t)5 * MP * 4, W_ZERO = W_BAR + 16384, W_END = W_ZERO + 32768;

struct Params { const float* in[25]; float* out; unsigned char* ws; int ph_lo, ph_hi; };

__device__ __forceinline__ void unpack8(const uint4 v, float* f) {
    f[0] = __uint_as_float(v.x << 16); f[1] = __uint_as_float(v.x & 0xffff0000u); f[2] = __uint_as_float(v.y << 16); f[3] = __uint_as_float(v.y & 0xffff0000u);
    f[4] = __uint_as_float(v.z << 16); f[5] = __uint_as_float(v.z & 0xffff0000u); f[6] = __uint_as_float(v.w << 16); f[7] = __uint_as_float(v.w & 0xffff0000u);
}
__device__ __forceinline__ uint4 pack8(const float* f) {
    uint4 r; r.x = pg8::cvt_pk_bf16(f[0], f[1]); r.y = pg8::cvt_pk_bf16(f[2], f[3]); r.z = pg8::cvt_pk_bf16(f[4], f[5]); r.w = pg8::cvt_pk_bf16(f[6], f[7]); return r;
}
__device__ __forceinline__ void load8f(const float* q, float* f) { const f4 a = *(const f4*)q, b = *(const f4*)(q + 4); f[0] = a.x; f[1] = a.y; f[2] = a.z; f[3] = a.w; f[4] = b.x; f[5] = b.y; f[6] = b.z; f[7] = b.w; }
__device__ __forceinline__ void store8f(float* q, const float* f) { *(f4*)q = (f4){f[0], f[1], f[2], f[3]}; *(f4*)(q + 4) = (f4){f[4], f[5], f[6], f[7]}; }
__device__ __forceinline__ float silu_f(float x) { return x * __builtin_amdgcn_rcpf(1.0f + __expf(-x)); }
__device__ __forceinline__ void row_decode(int row, int& isP, int& b, int& t) {
    if (row < T_P) { isP = 1; b = row / LP; t = row - b * LP; } else { isP = 0; const int r = row - T_P; b = r >> 3; t = r & 7; }
}

struct EpiScale {
    static constexpr bool PERM = true, AFTER_DRAIN = false, INIT_ACC = false;
    bf16_t* O0; int ld0, ncol0; bf16_t* O1; int ld1, ncol1; float* DT; const float* ss;
    __device__ __forceinline__ void pre(float (&aux)[8], const pg8::Unit& u, int wr, int wc, int fr, int fq) const {
        const int row0 = u.pm * 256 + wr * 64 + fr;
#pragma unroll
        for (int ai = 0; ai < 2; ++ai)
#pragma unroll
            for (int m = 0; m < 4; ++m) aux[ai * 4 + m] = ss[row0 + ai * 128 + m * 16];
    }
    __device__ __forceinline__ void operator()(const pg8::f32x4 (&acc)[2][2][4][2], const float (&aux)[8], const pg8::Unit& u, int wr, int wc, int fr, int fq) const {
        const int row0 = u.pm * 256 + wr * 64 + fr; const int colt = u.pn * 256;
        bf16_t* base; int ld; bool isdt = false;
        if (colt < ncol0) { base = O0 + colt; ld = ld0; } else if (colt < ncol0 + ncol1) { base = O1 + (colt - ncol0); ld = ld1; } else { base = O0; ld = 0; isdt = true; }
        const int col0 = wc * 32 + 8 * fq;
#pragma unroll
        for (int ai = 0; ai < 2; ++ai)
#pragma unroll
            for (int m = 0; m < 4; ++m) {
                const int row = row0 + ai * 128 + m * 16;
                const float rs = __builtin_amdgcn_rsqf(aux[ai * 4 + m] * (1.0f / 1024.0f) + EPS);
                if (!isdt) {
                    bf16_t* rowp = base + (size_t)row * ld + col0;
#pragma unroll
                    for (int bj = 0; bj < 2; ++bj) {
                        const pg8::f32x4 v0 = acc[ai][bj][m][0] * rs, v1 = acc[ai][bj][m][1] * rs;
                        pg8::u32x4 w; w.x = pg8::cvt_pk_bf16(v0[0], v0[1]); w.y = pg8::cvt_pk_bf16(v0[2], v0[3]); w.z = pg8::cvt_pk_bf16(v1[0], v1[1]); w.w = pg8::cvt_pk_bf16(v1[2], v1[3]);
                        *(pg8::u32x4*)(rowp + bj * 128) = w;
                    }
                } else if (wc == 0) {
                    float* q = DT + (size_t)row * 32 + 8 * fq;
                    *(pg8::f32x4*)q = acc[ai][0][m][0] * rs; *(pg8::f32x4*)(q + 4) = acc[ai][0][m][1] * rs;
                }
            }
    }
};
template <int N> __device__ __forceinline__ float row_ror(float x) { return __int_as_float(__builtin_amdgcn_update_dpp(0, __float_as_int(x), 0x120 + N, 0xf, 0xf, false)); }
struct EpiSsm {
    static constexpr bool PERM = true, AFTER_DRAIN = false, INIT_ACC = false;
    bf16_t* Zo; bf16_t* RAW; bf16_t* XC; float* DTS; const float* ss; const float* cw; const float* cb; const float* dtb;
    __device__ __forceinline__ void pre(float (&aux)[8], const pg8::Unit& u, int wr, int wc, int fr, int fq) const {
        const int row0 = u.pm * 256 + wr * 64 + fr;
#pragma unroll
        for (int ai = 0; ai < 2; ++ai)
#pragma unroll
            for (int m = 0; m < 4; ++m) aux[ai * 4 + m] = ss[row0 + ai * 128 + m * 16];
    }
    __device__ __forceinline__ void operator()(const pg8::f32x4 (&acc)[2][2][4][2], const float (&aux)[8], const pg8::Unit& u, int wr, int wc, int fr, int fq) const {
        const int rowb = u.pm * 256 + wr * 64 + fr;
        pg8::u32x4 pk[2][2][4];
#pragma unroll
        for (int ai = 0; ai < 2; ++ai)
#pragma unroll
            for (int m = 0; m < 4; ++m) { const float rs = __builtin_amdgcn_rsqf(aux[ai * 4 + m] * (1.0f / 1024.0f) + EPS);
#pragma unroll
                for (int bj = 0; bj < 2; ++bj) { const pg8::f32x4 v0 = acc[ai][bj][m][0] * rs, v1 = acc[ai][bj][m][1] * rs;
                    pk[ai][bj][m].x = pg8::cvt_pk_bf16(v0[0], v0[1]); pk[ai][bj][m].y = pg8::cvt_pk_bf16(v0[2], v0[3]); pk[ai][bj][m].z = pg8::cvt_pk_bf16(v1[0], v1[1]); pk[ai][bj][m].w = pg8::cvt_pk_bf16(v1[2], v1[3]); }
                if (u.pn == 20 && wc == 0) {
                    const int row = rowb + ai * 128 + m * 16; float bb[8], v[8]; load8f(dtb + 8 * fq, bb);
#pragma unroll
                    for (int n = 0; n < 2; ++n)
#pragma unroll
                        for (int jj = 0; jj < 4; ++jj) { const float z = acc[ai][0][m][n][jj] * rs + bb[4 * n + jj]; v[4 * n + jj] = z > 20.f ? z : log1pf(__expf(z)); }
                    store8f(DTS + (size_t)row * 32 + 8 * fq, v);
                } }
        if (u.pn < 8) {
#pragma unroll
            for (int ai = 0; ai < 2; ++ai)
#pragma unroll
                for (int m = 0; m < 4; ++m)
#pragma unroll
                    for (int bj = 0; bj < 2; ++bj) *(pg8::u32x4*)(Zo + (size_t)(rowb + ai * 128 + m * 16) * 2048 + u.pn * 256 + bj * 128 + wc * 32 + 8 * fq) = pk[ai][bj][m];
        } else if (u.pn < 20) {
#pragma unroll
            for (int bj = 0; bj < 2; ++bj) {
                const int ch = (u.pn - 8) * 256 + bj * 128 + wc * 32 + 8 * fq;
                float w0[8], w1[8], w2[8], w3[8], bi[8]; load8f(cw + ch, w0); load8f(cw + 3072 + ch, w1); load8f(cw + 2 * 3072 + ch, w2); load8f(cw + 3 * 3072 + ch, w3); load8f(cb + ch, bi);
#pragma unroll
                for (int ai = 0; ai < 2; ++ai) {
                    float p1[8], p2[8], p3[8];
#pragma unroll
                    for (int i = 0; i < 8; ++i) { p1[i] = 0.f; p2[i] = 0.f; p3[i] = 0.f; }
#pragma unroll
                    for (int m = 0; m < 4; ++m) {
                        const int row = rowb + ai * 128 + m * 16; const pg8::u32x4 raw = pk[ai][bj][m];
                        float uu[8], s1[8], s2[8], s3[8]; unpack8(make_uint4(raw.x, raw.y, raw.z, raw.w), uu);
#pragma unroll
                        for (int i = 0; i < 8; ++i) { s1[i] = row_ror<1>(uu[i]); s2[i] = row_ror<2>(uu[i]); s3[i] = row_ror<3>(uu[i]); }
                        int isP, b, t; row_decode(row, isP, b, t); const int Lr = isP ? LP : LS;
                        const bool defer = (m == 0 && fr < 3) || t < 3;
                        const bool wantRaw = defer || ((row & 63) >= 61) || t >= Lr - 3;
                        if (wantRaw) *(pg8::u32x4*)(RAW + (size_t)row * 3072 + ch) = raw;
                        float o[8];
#pragma unroll
                        for (int i = 0; i < 8; ++i) { const float t1 = fr >= 1 ? s1[i] : p1[i], t2 = fr >= 2 ? s2[i] : p2[i], t3 = fr >= 3 ? s3[i] : p3[i];
                            o[i] = silu_f(bi[i] + w0[i] * t3 + w1[i] * t2 + w2[i] * t1 + w3[i] * uu[i]); p1[i] = s1[i]; p2[i] = s2[i]; p3[i] = s3[i]; }
                        if (!defer) *(uint4*)(XC + (size_t)row * 3072 + ch) = pack8(o);
                    }
                }
            }
        }
    }
};
struct EpiFfn {
    static constexpr bool PERM = true, AFTER_DRAIN = false, INIT_ACC = false;
    bf16_t* U; bf16_t* A2; const float* ss; PG8_LAS const unsigned char* cwl;
    __device__ __forceinline__ void pre(float (&aux)[8], const pg8::Unit& u, int wr, int wc, int fr, int fq) const {
        const int row0 = u.pm * 256 + wr * 64 + fr;
#pragma unroll
        for (int ai = 0; ai < 2; ++ai)
#pragma unroll
            for (int m = 0; m < 4; ++m) aux[ai * 4 + m] = ss[row0 + ai * 128 + m * 16];
    }
    __device__ __forceinline__ void operator()(const pg8::f32x4 (&acc)[2][2][4][2], const float (&aux)[8], const pg8::Unit& u, int wr, int wc, int fr, int fq) const {
        const int rowb = u.pm * 256 + wr * 64 + fr; const int ch = u.pn * 128 + wc * 32 + 8 * fq;
        float w0[8], w1[8], w2[8];
        { const pg8::u32x4 r0 = *(const PG8_LAS pg8::u32x4*)(cwl + (size_t)ch * 2), r1 = *(const PG8_LAS pg8::u32x4*)(cwl + (size_t)(DFF + ch) * 2), r2 = *(const PG8_LAS pg8::u32x4*)(cwl + (size_t)(2 * DFF + ch) * 2);
          unpack8(make_uint4(r0.x, r0.y, r0.z, r0.w), w0); unpack8(make_uint4(r1.x, r1.y, r1.z, r1.w), w1); unpack8(make_uint4(r2.x, r2.y, r2.z, r2.w), w2); }
#pragma unroll
        for (int ai = 0; ai < 2; ++ai) {
            float p1[8], p2[8];
#pragma unroll
            for (int i = 0; i < 8; ++i) { p1[i] = 0.f; p2[i] = 0.f; }
#pragma unroll
            for (int m = 0; m < 4; ++m) {
                const int row = rowb + ai * 128 + m * 16; const float rs = __builtin_amdgcn_rsqf(aux[ai * 4 + m] * (1.0f / 1024.0f) + EPS);
                float uu[8], gg[8], s1[8], s2[8];
#pragma unroll
                for (int n = 0; n < 2; ++n)
#pragma unroll
                    for (int jj = 0; jj < 4; ++jj) { uu[4 * n + jj] = acc[ai][0][m][n][jj] * rs; gg[4 * n + jj] = acc[ai][1][m][n][jj] * rs; }
#pragma unroll
                for (int i = 0; i < 8; ++i) { s1[i] = row_ror<1>(uu[i]); s2[i] = row_ror<2>(uu[i]); }
                int isP, b, t; row_decode(row, isP, b, t); const int Lr = isP ? LP : LS;
                const bool defer = (m == 0 && fr < 2) || t < 2;
                const bool wantU = defer || ((row & 63) >= 62) || t >= Lr - 2;
                if (wantU) *(uint4*)(U + (size_t)row * DFF + ch) = pack8(uu);
                float o[8];
#pragma unroll
                for (int i = 0; i < 8; ++i) { const float t1 = fr >= 1 ? s1[i] : p1[i], t2 = fr >= 2 ? s2[i] : p2[i]; o[i] = defer ? gg[i] : silu_f(w0[i] * t2 + w1[i] * t1 + w2[i] * uu[i]) * gg[i]; p1[i] = s1[i]; p2[i] = s2[i]; }
                *(uint4*)(A2 + (size_t)row * DFF + ch) = pack8(o);
            }
        }
    }
};
struct EpiResid {
    static constexpr bool PERM = true, AFTER_DRAIN = false, INIT_ACC = true;
    bf16_t* Xb; float* ssn;
    __device__ __forceinline__ void init(pg8::f32x4 (&acc)[2][2][4][2], const pg8::Unit& u, int wr, int wc, int fr, int fq) const {
        const bool full = u.q < 0;
        const int row0 = u.pm * 256 + (full ? 0 : (u.q >> 1) * 128) + wr * 64 + fr; const int col0 = u.pn * 256 + (full ? 0 : (u.q & 1) * 128) + wc * 32 + 8 * fq;
        pg8::u32x4 raw[2][4][2];
#pragma unroll
        for (int ai = 0; ai < 2; ++ai)
#pragma unroll
            for (int m = 0; m < 4; ++m)
#pragma unroll
                for (int bj = 0; bj < 2; ++bj) { raw[ai][m][bj] = (pg8::u32x4){0u, 0u, 0u, 0u}; if (full || (ai == 0 && bj == 0)) raw[ai][m][bj] = *(const pg8::u32x4*)(Xb + (size_t)(row0 + ai * 128 + m * 16) * 1024 + col0 + bj * 128); }
#pragma unroll
        for (int ai = 0; ai < 2; ++ai)
#pragma unroll
            for (int m = 0; m < 4; ++m)
#pragma unroll
                for (int bj = 0; bj < 2; ++bj) { const pg8::u32x4 v = raw[ai][m][bj];
                    acc[ai][bj][m][0] = (pg8::f32x4){__uint_as_float(v.x << 16), __uint_as_float(v.x & 0xffff0000u), __uint_as_float(v.y << 16), __uint_as_float(v.y & 0xffff0000u)};
                    acc[ai][bj][m][1] = (pg8::f32x4){__uint_as_float(v.z << 16), __uint_as_float(v.z & 0xffff0000u), __uint_as_float(v.w << 16), __uint_as_float(v.w & 0xffff0000u)}; }
    }
    __device__ __forceinline__ void pre(float (&aux)[8], const pg8::Unit&, int, int, int, int) const {
#pragma unroll
        for (int i = 0; i < 8; ++i) aux[i] = 0.f;
    }
    __device__ __forceinline__ void operator()(const pg8::f32x4 (&acc)[2][2][4][2], const float (&aux)[8], const pg8::Unit& u, int wr, int wc, int fr, int fq) const {
        const bool full = u.q < 0;
        const int row0 = u.pm * 256 + (full ? 0 : (u.q >> 1) * 128) + wr * 64 + fr; const int col0 = u.pn * 256 + (full ? 0 : (u.q & 1) * 128) + wc * 32 + 8 * fq;
#pragma unroll
        for (int ai = 0; ai < 2; ++ai) {
            if (ai == 1 && !full) break;
#pragma unroll
            for (int m = 0; m < 4; ++m) {
                const int row = row0 + ai * 128 + m * 16; float s = 0.f;
#pragma unroll
                for (int bj = 0; bj < 2; ++bj) {
                    if (bj == 1 && !full) break;
                    const pg8::f32x4 v0 = acc[ai][bj][m][0], v1 = acc[ai][bj][m][1];
                    pg8::u32x4 w; w.x = pg8::cvt_pk_bf16(v0[0], v0[1]); w.y = pg8::cvt_pk_bf16(v0[2], v0[3]); w.z = pg8::cvt_pk_bf16(v1[0], v1[1]); w.w = pg8::cvt_pk_bf16(v1[2], v1[3]);
                    *(pg8::u32x4*)(Xb + (size_t)row * 1024 + col0 + bj * 128) = w;
                    s += v0[0] * v0[0] + v0[1] * v0[1] + v0[2] * v0[2] + v0[3] * v0[3] + v1[0] * v1[0] + v1[1] * v1[1] + v1[2] * v1[2] + v1[3] * v1[3];
                }
                s += __shfl_xor(s, 16); s += __shfl_xor(s, 32);
                if (fq == 0) atomicAdd(ssn + row, s);
            }
        }
    }
};
template <class Epi, class Sched> __device__ __forceinline__ void run_gemm_s(PG8_LAS unsigned char* lds, const bf16_t* A, const bf16_t* Bt, int N, int K, const Epi& E) {
    pg8::Gemm g{A, Bt, MP, N, K}; Sched S; S.init(MP, N, (int)gridDim.x, (int)blockIdx.x);
    pg8::gemm_phase<Epi, Sched, false>(lds, g, S, E, nullptr);
}
template <class Epi> __device__ __forceinline__ void run_gemm(PG8_LAS unsigned char* lds, const bf16_t* A, const bf16_t* Bt, int N, int K, const Epi& E) {
    pg8::Gemm g{A, Bt, MP, N, K}; pg8::StaticOrder S; S.init(MP, N, (int)gridDim.x, (int)blockIdx.x);
    pg8::gemm_phase<Epi, pg8::StaticOrder, false>(lds, g, S, E, nullptr);
}

__device__ __forceinline__ void convert_tiles(const Params& p, float* tile  , int lo, int hi, int widx, int wcnt) {
    const int tid = threadIdx.x; unsigned char* ws = p.ws;
    constexpr int NJ = 10;
    const int jt[NJ + 1] = {0, 192, 256, 432, 608, 784, 1120, 1248, 1424, 1600, 1776};
    for (int gt = lo + widx; gt < hi; gt += wcnt) {
        int j = 0;
#pragma unroll
        for (int q = 1; q < NJ; ++q) if (gt >= jt[q]) j = q;
        const int lt = gt - jt[j];
        const float* src; const float* scale = nullptr; bf16_t* dst; int K = 1024, N, Npad; int ilv = -1;
        switch (j) {
            case 0: src = p.in[10]; scale = p.in[7]; dst = (bf16_t*)(ws + W_SC_IN); N = 3072; Npad = 3072; break;
            case 1: src = p.in[12]; dst = (bf16_t*)(ws + W_SC_OUT); N = 1024; Npad = 1024; break;
            case 2: src = p.in[21]; scale = p.in[8]; dst = (bf16_t*)(ws + W_UG0); N = DFF; Npad = DFF; ilv = 0; break;
            case 3: src = p.in[22]; scale = p.in[8]; dst = (bf16_t*)(ws + W_UG0); N = DFF; Npad = DFF; ilv = 128; break;
            case 4: src = p.in[24]; dst = (bf16_t*)(ws + W_DN0); K = DFF; N = 1024; Npad = 1024; break;
            case 5: src = p.in[13]; scale = p.in[7] + 1024; dst = (bf16_t*)(ws + W_SSM_IN); N = 5152; Npad = NINP; break;
            case 6: src = p.in[20]; dst = (bf16_t*)(ws + W_SSM_OUT); K = 2048; N = 1024; Npad = 1024; break;
            case 7: src = p.in[21] + (size_t)1024 * DFF; scale = p.in[8] + 1024; dst = (bf16_t*)(ws + W_UG1); N = DFF; Npad = DFF; ilv = 0; break;
            case 8: src = p.in[22] + (size_t)1024 * DFF; scale = p.in[8] + 1024; dst = (bf16_t*)(ws + W_UG1); N = DFF; Npad = DFF; ilv = 128; break;
            default: src = p.in[24] + (size_t)DFF * 1024; dst = (bf16_t*)(ws + W_DN1); K = DFF; N = 1024; Npad = 1024; break;
        }
        const int ntn = Npad / 256; const int k0 = (lt / ntn) * 64, n0 = (lt % ntn) * 256;
        const int nn = tid & 255, kh = tid >> 8;
        float v[32];
#pragma unroll
        for (int i = 0; i < 32; ++i) v[i] = (n0 + nn < N) ? src[(size_t)(k0 + i * 2 + kh) * N + n0 + nn] : 0.f;
        if (scale) {
#pragma unroll
            for (int i = 0; i < 32; ++i) v[i] *= scale[k0 + i * 2 + kh];
        }
        __syncthreads();
#pragma unroll
        for (int i = 0; i < 32; ++i) tile[(i * 2 + kh) * 257 + nn] = v[i];
        __syncthreads();
#pragma unroll
        for (int i = 0; i < 16; ++i) {
            const int n2 = i * 16 + (tid >> 5), kk = (tid & 31) * 2;
            const int nc_ = n0 + n2; const int drow = ilv < 0 ? nc_ : ((nc_ >> 7) * 256 + (nc_ & 127) + ilv);
            *(unsigned*)(dst + (size_t)drow * K + k0 + kk) = pg8::cvt_pk_bf16(tile[kk * 257 + n2], tile[(kk + 1) * 257 + n2]);
        }
    }
    __syncthreads();
}
__device__ __forceinline__ void phase_prep(const Params& p, float* tile) {
    const int tid = threadIdx.x; unsigned char* ws = p.ws;
    convert_tiles(p, tile, 0, 192, (int)blockIdx.x, (int)gridDim.x);
    for (int q = blockIdx.x * 512 + tid; q < 8192; q += gridDim.x * 512) ((float*)(ws + W_ZERO))[q] = 0.f;
    bf16_t* Xb = (bf16_t*)(ws + W_XB); float* SS = (float*)(ws + W_SS);
    const int lane = tid & 63, wv = tid >> 6; constexpr int NR = 3; const int rstride = gridDim.x * 8;
    for (int row0 = blockIdx.x * 8 + wv; row0 < MP; row0 += NR * rstride) {
        f4 v[NR][4];
#pragma unroll
        for (int u = 0; u < NR; ++u) { const int row = row0 + u * rstride; const float* src = nullptr;
            if (row < T_P) { const int b = row / LP, t = row - b * LP; src = t < NMETA ? p.in[6] + (size_t)t * 1024 : p.in[0] + ((size_t)b * 2048 + (t - NMETA)) * 1024; }
            else if (row < T) src = p.in[1] + (size_t)(row - T_P) * 1024;
#pragma unroll
            for (int i = 0; i < 4; ++i) { v[u][i] = (f4){0.f, 0.f, 0.f, 0.f}; if (src) v[u][i] = *(const f4*)(src + i * 256 + lane * 4); } }
#pragma unroll
        for (int u = 0; u < NR; ++u) { const int row = row0 + u * rstride; float s = 0.f;
#pragma unroll
            for (int i = 0; i < 4; ++i) { const f4 x = v[u][i];
                if (row < MP) { uint2 w; w.x = pg8::cvt_pk_bf16(x.x, x.y); w.y = pg8::cvt_pk_bf16(x.z, x.w); *(uint2*)(Xb + (size_t)row * 1024 + i * 256 + lane * 4) = w; }
                s += x.x * x.x + x.y * x.y + x.z * x.z + x.w * x.w; }
#pragma unroll
            for (int o = 32; o >= 1; o >>= 1) s += __shfl_xor(s, o);
            if (lane == 0 && row < MP) { SS[row] = s; SS[MP + row] = 0.f; SS[2 * MP + row] = 0.f; SS[3 * MP + row] = 0.f; SS[4 * MP + row] = 0.f; }
        }
    }
}
__device__ __forceinline__ void phase_sc_conv(const Params& p) {
    const bf16_t* BCX = (const bf16_t*)(p.ws + W_BIG); bf16_t* A1 = (bf16_t*)(p.ws + W_ABUF);
    const float* cw = p.in[11]; const float* cache = p.in[2];
    constexpr int R = 8, NIT = (T / R) * 128; const int stride = gridDim.x * 512;
    for (int idx = blockIdx.x * 512 + threadIdx.x; idx < NIT; idx += stride) {
        const int r0 = (idx >> 7) * R, c = (idx & 127) * 8; int isP, b, t0; row_decode(r0, isP, b, t0);
        uint4 rc[R + 2], rx[R + 2], rb[R];
#pragma unroll
        for (int i = 0; i < R + 2; ++i) { const int r = (t0 == 0 && i < 2) ? r0 : r0 + i - 2; const bf16_t* q = BCX + (size_t)r * 3072 + c; rc[i] = *(const uint4*)(q + 1024); rx[i] = *(const uint4*)(q + 2048); }
#pragma unroll
        for (int i = 0; i < R; ++i) rb[i] = *(const uint4*)(BCX + (size_t)(r0 + i) * 3072 + c);
        float w[3][8];
#pragma unroll
        for (int k = 0; k < 3; ++k) load8f(cw + k * 1024 + c, w[k]);
        float cx[R + 2][8];
#pragma unroll
        for (int i = 0; i < R + 2; ++i) { float xv[8]; unpack8(rc[i], cx[i]); unpack8(rx[i], xv);
#pragma unroll
            for (int j = 0; j < 8; ++j) cx[i][j] *= xv[j]; }
        if (t0 == 0) {
#pragma unroll
            for (int i = 0; i < 2; ++i) { if (!isP) load8f(cache + ((size_t)b * 2 + i) * 1024 + c, cx[i]); else {
#pragma unroll
                for (int j = 0; j < 8; ++j) cx[i][j] = 0.f; } }
        }
#pragma unroll
        for (int i = 0; i < R; ++i) { float bg[8], o[8]; unpack8(rb[i], bg);
#pragma unroll
            for (int j = 0; j < 8; ++j) o[j] = bg[j] * (w[0][j] * cx[i][j] + w[1][j] * cx[i + 1][j] + w[2][j] * cx[i + 2][j]);
            *(uint4*)(A1 + (size_t)(r0 + i) * 1024 + c) = pack8(o); }
        const int Lr = isP ? LP : LS;
        if (t0 + R == Lr) { float* o = p.out + (isP ? O2 : O6) + (size_t)b * 2 * 1024 + c; store8f(o, cx[R]); store8f(o + 1024, cx[R + 1]); }
    }
}
__device__ __forceinline__ void phase_ffn_fix(const Params& p, int li) {
    const bf16_t* U = (const bf16_t*)(p.ws + W_BIG); bf16_t* A2 = (bf16_t*)(p.ws + W_ABUF);
    const float* cw = p.in[23] + (size_t)li * 3 * DFF; const float* cache = p.in[5] + (size_t)li * NSB * 2 * DFF;
    constexpr int NB64 = MP / 64, NR = NB64 * 2 + 12 + 224, NIT = NR * 352; const int stride = gridDim.x * 512;
    for (int idx = blockIdx.x * 512 + threadIdx.x; idx < NIT; idx += stride) {
        const int ri = idx / 352, c = (idx - ri * 352) * 8; int row;
        if (ri < NB64 * 2) row = 64 * (ri >> 1) + (ri & 1);
        else if (ri < NB64 * 2 + 12) { const int k = ri - NB64 * 2, q = k >> 1, bb = q < 3 ? q + 1 : q + 2; row = bb * LP + (k & 1); }
        else { const int k = ri - NB64 * 2 - 12, sp = k >> 1, s = sp + sp / 7 + 1; row = T_P + 8 * s + (k & 1); }
        if (row >= T) continue;
        int isP, b, t; row_decode(row, isP, b, t);
        uint4 rawu[3];
#pragma unroll
        for (int k = 0; k < 3; ++k) { const int rk = (t - 2 + k >= 0) ? row - 2 + k : row; rawu[k] = *(const uint4*)(U + (size_t)rk * DFF + c); }
        const uint4 rawg = *(const uint4*)(A2 + (size_t)row * DFF + c);
        float acc[8];
#pragma unroll
        for (int j = 0; j < 8; ++j) acc[j] = 0.f;
#pragma unroll
        for (int k = 0; k < 3; ++k) {
            const int tp = t - 2 + k; float uu[8]; unpack8(rawu[k], uu);
            if (tp < 0) { if (!isP) load8f(cache + ((size_t)b * 2 + (2 + tp)) * DFF + c, uu); else {
#pragma unroll
                for (int j = 0; j < 8; ++j) uu[j] = 0.f; } }
            float w[8]; load8f(cw + k * DFF + c, w);
#pragma unroll
            for (int j = 0; j < 8; ++j) acc[j] += w[j] * uu[j];
        }
        float g[8]; unpack8(rawg, g);
#pragma unroll
        for (int j = 0; j < 8; ++j) acc[j] = silu_f(acc[j]) * g[j];
        *(uint4*)(A2 + (size_t)row * DFF + c) = pack8(acc);
    }
    for (int idx = blockIdx.x * 512 + threadIdx.x; idx < (NBP + NSB) * 2 * 352; idx += stride) {
        const int sj = idx / 352, c = (idx - sj * 352) * 8, sq = sj >> 1, j = sj & 1;
        const int isP = sq < NBP, b = isP ? sq : sq - NBP; const int row = isP ? b * LP + LP - 2 + j : T_P + b * LS + LS - 2 + j;
        float uu[8]; unpack8(*(const uint4*)(U + (size_t)row * DFF + c), uu);
        store8f(p.out + (isP ? O5 + ((size_t)(li * NBP + b) * 2 + j) * DFF : O9 + ((size_t)(li * NSB + b) * 2 + j) * DFF) + c, uu);
    }
}
__device__ __forceinline__ void phase_ssm_fix(const Params& p) {
    const bf16_t* RAW = (const bf16_t*)(p.ws + W_BIG) + (size_t)MP * 2048; bf16_t* XC = (bf16_t*)(p.ws + W_ABUF);
    const float* cw = p.in[14]; const float* cb = p.in[15]; const float* cache = p.in[3];
    constexpr int NB64 = MP / 64, NR = NB64 * 3 + 18 + 336, NIT = NR * 384; const int stride = gridDim.x * 512;
    for (int idx = blockIdx.x * 512 + threadIdx.x; idx < NIT; idx += stride) {
        const int ri = idx / 384, c = (idx - ri * 384) * 8; int row;
        if (ri < NB64 * 3) { const int k = ri / 3; row = 64 * k + (ri - 3 * k); }
        else if (ri < NB64 * 3 + 18) { const int k = ri - NB64 * 3, q = k / 3, bb = q < 3 ? q + 1 : q + 2; row = bb * LP + (k - 3 * q); }
        else { const int k = ri - NB64 * 3 - 18, sp = k / 3, s = sp + sp / 7 + 1; row = T_P + 8 * s + (k - 3 * sp); }
        if (row >= T) continue;
        int isP, b, t; row_decode(row, isP, b, t);
        uint4 rawu[4];
#pragma unroll
        for (int k = 0; k < 4; ++k) { const int rk = (t - 3 + k >= 0) ? row - 3 + k : row; rawu[k] = *(const uint4*)(RAW + (size_t)rk * 3072 + c); }
        float acc[8]; load8f(cb + c, acc);
#pragma unroll
        for (int k = 0; k < 4; ++k) {
            const int tp = t - 3 + k; float uu[8]; unpack8(rawu[k], uu);
            if (tp < 0) { if (!isP) load8f(cache + ((size_t)b * 3 + (3 + tp)) * 3072 + c, uu); else {
#pragma unroll
                for (int j = 0; j < 8; ++j) uu[j] = 0.f; } }
            float w[8]; load8f(cw + k * 3072 + c, w);
#pragma unroll
            for (int j = 0; j < 8; ++j) acc[j] += w[j] * uu[j];
        }
#pragma unroll
        for (int j = 0; j < 8; ++j) acc[j] = silu_f(acc[j]);
        *(uint4*)(XC + (size_t)row * 3072 + c) = pack8(acc);
    }
    for (int idx = blockIdx.x * 512 + threadIdx.x; idx < (NBP + NSB) * 3 * 384; idx += stride) {
        const int sj = idx / 384, c = (idx - sj * 384) * 8, sq = sj / 3, j = sj - 3 * sq;
        const int isP = sq < NBP, b = isP ? sq : sq - NBP; const int row = isP ? b * LP + LP - 3 + j : T_P + b * LS + LS - 3 + j;
        float uu[8]; unpack8(*(const uint4*)(RAW + (size_t)row * 3072 + c), uu);
        store8f(p.out + (isP ? O3 : O7) + ((size_t)b * 3 + j) * 3072 + c, uu);
    }
}
typedef float f32x16 __attribute__((ext_vector_type(16)));
typedef short s16x4 __attribute__((ext_vector_type(4)));
typedef unsigned u32x2 __attribute__((ext_vector_type(2)));
constexpr int SI_C = 0, SI_B = 32768, SI_X = 65536, SI_M = 98304, SI_S = 131072, SI_CUM = 147456, SI_DT = SI_CUM + 512, SI_WG = SI_DT + 512, SI_AD = SI_WG + 512, SSD_LDS = SI_AD + 256;
__device__ __forceinline__ unsigned off_b(unsigned row, unsigned ch) { return 256u * row + 16u * (ch ^ (((row & 3u) << 2) | ((row >> 2) & 3u))); }
__device__ __forceinline__ pg8::bf16x8 rd_row(LAS unsigned char* img, unsigned row, unsigned ks, unsigned hh) { return *(const LAS pg8::bf16x8*)(img + off_b(row, 2u * ks + hh)); }
__device__ __forceinline__ pg8::bf16x8 rd_tr(LAS unsigned char* img, unsigned lane, unsigned c, unsigned ks) {
    const unsigned h = lane >> 5, blk = (lane >> 4) & 1u, q = (lane & 15u) >> 2, pp = lane & 3u;
    const s16x4 lo = __builtin_amdgcn_ds_read_tr16_b64_v4i16((LAS s16x4*)(img + off_b(16u * ks + 8u * h + q, 4u * c + 2u * blk + (pp >> 1)) + 8u * (pp & 1u)));
    const s16x4 hi = __builtin_amdgcn_ds_read_tr16_b64_v4i16((LAS s16x4*)(img + off_b(16u * ks + 8u * h + 4u + q, 4u * c + 2u * blk + (pp >> 1)) + 8u * (pp & 1u)));
    return (pg8::bf16x8){lo[0], lo[1], lo[2], lo[3], hi[0], hi[1], hi[2], hi[3]};
}
#define SSD_BAR() do { asm volatile("s_waitcnt lgkmcnt(0)" ::: "memory"); __builtin_amdgcn_s_barrier(); asm volatile("" ::: "memory"); } while (0)
__device__ __forceinline__ void phase_ssd(const Params& p, LAS unsigned char* lds) {
    const bf16_t* XC = (const bf16_t*)(p.ws + W_ABUF); const bf16_t* Z = (const bf16_t*)(p.ws + W_BIG); bf16_t* Y = (bf16_t*)(p.ws + W_BIG) + (size_t)MP * 2048;
    const float* DTS = (const float*)(p.ws + W_DTS);
    const int tid = threadIdx.x, lane = tid & 63, w = __builtin_amdgcn_readfirstlane(tid >> 6), hh = lane >> 5, l31 = lane & 31;
    const int lt = w >> 1, pt = w & 1;
    LAS float* cumL = (LAS float*)(lds + SI_CUM); LAS float* dtL = (LAS float*)(lds + SI_DT); LAS float* wgL = (LAS float*)(lds + SI_WG); LAS float* aL = (LAS float*)(lds + SI_AD); LAS float* dL = aL + 32;
    if (tid < 32) { aL[tid] = -__expf(p.in[17][tid]); dL[tid] = p.in[18][tid]; }
    __syncthreads();
    const int lrow = lt * 32 + l31;
    constexpr int NITEMS = 256 + NSB * NH;
    int item = blockIdx.x; if (item >= NITEMS) return;
    int isP, b, h, g, row0, L, nch; float a, dsk; size_t sbase;
#define SSD_DECODE(it) do { if ((it) < 256) { isP = 1; const int pr_ = ((it) & 7) * 4 + ((it) >> 6); b = pr_ >> 2; h = (pr_ & 3) * 8 + (((it) >> 3) & 7); }     \
         else { isP = 0; b = ((it) - 256) >> 5; h = ((it) - 256) & 31; } \
        g = h >> 3; row0 = isP ? b * LP : T_P + b * LS; L = isP ? LP : LS; nch = (L + 127) >> 7; a = aL[h]; dsk = dL[h]; \
        sbase = ((size_t)(b * NH + h) * 64 + (pt * 32 + l31)) * 128 + lt * 32 + 4 * hh; } while (0)
    pg8::u32x4 rC[4], rB[4], rX[2]; float dtr[2]; f4 s0r[4];
#define SSD_LOAD(row0_, L_, h_, g_, cc) do { const int t0_ = (cc) * 128; const int rmax_ = (L_) - t0_ - 1;     \
            _Pragma("unroll") for (int i = 0; i < 4; ++i) { int r_ = (tid >> 4) + 32 * i; r_ = r_ < rmax_ ? r_ : rmax_; const int ch_ = tid & 15; \
                const bf16_t* q_ = XC + (size_t)((row0_) + t0_ + r_) * 3072 + 2048 + (g_) * 128 + ch_ * 8; rB[i] = *(const pg8::u32x4*)q_; rC[i] = *(const pg8::u32x4*)(q_ + 512); } \
            _Pragma("unroll") for (int i = 0; i < 2; ++i) { int r_ = (tid >> 3) + 64 * i; r_ = r_ < rmax_ ? r_ : rmax_; const int ch_ = tid & 7; \
                rX[i] = *(const pg8::u32x4*)(XC + (size_t)((row0_) + t0_ + r_) * 3072 + (h_) * 64 + ch_ * 8); } \
            { int r0_ = 2 * lane, r1_ = 2 * lane + 1; r0_ = r0_ < rmax_ ? r0_ : rmax_; r1_ = r1_ < rmax_ ? r1_ : rmax_; \
              dtr[0] = DTS[(size_t)((row0_) + t0_ + r0_) * 32 + (h_)]; dtr[1] = DTS[(size_t)((row0_) + t0_ + r1_) * 32 + (h_)]; } } while (0)
#define SSD_LOAD_S0(ptr_) do { _Pragma("unroll") for (int q = 0; q < 4; ++q) s0r[q] = *(const f4*)((ptr_) + 8 * q); } while (0)
    const float* zpage = (const float*)(p.ws + W_ZERO) + ((pt * 32 + l31) * 128 + lt * 32 + 4 * hh);
#define SSD_WRITE_S() do { _Pragma("unroll") for (int q = 0; q < 4; ++q) { u32x2 wv; wv.x = pg8::cvt_pk_bf16(accS[4 * q], accS[4 * q + 1]); wv.y = pg8::cvt_pk_bf16(accS[4 * q + 2], accS[4 * q + 3]); \
            *(LAS u32x2*)(lds + SI_S + 8192u * pt + (sW ^ (64u * lt + 16u * q))) = wv; } } while (0)
    unsigned rowL = off_b(l31, hh);
    unsigned mW = off_b(lrow, 0) + 8u * hh;
    unsigned sW = off_b(l31, 0) + 8u * hh;
    unsigned trX0, trX1, trB0, trB1;
    { const unsigned h_ = lane >> 5, blk = (lane >> 4) & 1u, q_ = (lane & 15u) >> 2, pp = lane & 3u;
      trX0 = off_b(8u * h_ + q_, 4u * pt + 2u * blk + (pp >> 1)) + 8u * (pp & 1u); trX1 = off_b(8u * h_ + 4u + q_, 4u * pt + 2u * blk + (pp >> 1)) + 8u * (pp & 1u);
      trB0 = off_b(8u * h_ + q_, 4u * lt + 2u * blk + (pp >> 1)) + 8u * (pp & 1u); trB1 = off_b(8u * h_ + 4u + q_, 4u * lt + 2u * blk + (pp >> 1)) + 8u * (pp & 1u); }
    unsigned stg = off_b((unsigned)tid >> 4, (unsigned)tid & 15u), stgX = off_b((unsigned)tid >> 3, (unsigned)tid & 7u);
#define RROW(img, tile, ks) (*(const LAS pg8::bf16x8*)(lds + (img) + 8192u * (tile) + (rowL ^ (32u * (ks)))))
#define RTR(img, b0, b1, ks) ({ const s16x4 lo_ = __builtin_amdgcn_ds_read_tr16_b64_v4i16((LAS s16x4*)(lds + (img) + (b0) + 4096u * (ks))); const s16x4 hi_ = __builtin_amdgcn_ds_read_tr16_b64_v4i16((LAS s16x4*)(lds + (img) + (b1) + 4096u * (ks))); \
        (pg8::bf16x8){lo_[0], lo_[1], lo_[2], lo_[3], hi_[0], hi_[1], hi_[2], hi_[3]}; })
    SSD_DECODE(item);
    dtr[0] = 0.f; dtr[1] = 0.f;
    SSD_LOAD(row0, L, h, g, 0); SSD_LOAD_S0(isP ? zpage : p.in[4] + sbase);
    f32x16 accS;
    int c = 0;
    for (;;) {
        asm volatile("" : "+v"(rowL), "+v"(mW), "+v"(sW), "+v"(trX0), "+v"(trX1), "+v"(trB0), "+v"(trB1), "+v"(stg), "+v"(stgX));
        if (c == 0) {
#pragma unroll
            for (int q = 0; q < 4; ++q) { accS[4 * q] = s0r[q].x; accS[4 * q + 1] = s0r[q].y; accS[4 * q + 2] = s0r[q].z; accS[4 * q + 3] = s0r[q].w; }
            SSD_WRITE_S();
        }
        const int t0 = c * 128; const int nv = (L - t0) < 128 ? (L - t0) : 128; const int ksmax = (nv + 15) >> 4;
#pragma unroll
        for (int i = 0; i < 4; ++i) { const bool ok_ = (tid >> 4) + 32 * i < nv; const pg8::u32x4 z4 = (pg8::u32x4){0u, 0u, 0u, 0u}; *(LAS pg8::u32x4*)(lds + SI_C + stg + 8192u * i) = ok_ ? rC[i] : z4; *(LAS pg8::u32x4*)(lds + SI_B + stg + 8192u * i) = ok_ ? rB[i] : z4; }
#pragma unroll
        for (int i = 0; i < 2; ++i) { const bool ok_ = (tid >> 3) + 64 * i < nv; *(LAS pg8::u32x4*)(lds + SI_X + stgX + 16384u * i) = ok_ ? rX[i] : (pg8::u32x4){0u, 0u, 0u, 0u}; }
        if (w == 0) {
            const float dt0 = (2 * lane < nv) ? dtr[0] : 0.f, dt1 = (2 * lane + 1 < nv) ? dtr[1] : 0.f;
            const float d0 = dt0 * a, d1 = dt1 * a, ps = d0 + d1; float incl = ps;
#pragma unroll
            for (int o = 1; o < 64; o <<= 1) { const float v = __shfl_up(incl, o); if (lane >= o) incl += v; }
            const float c0 = incl - ps + d0, c1 = incl, clast = __shfl(incl, 63);
            cumL[2 * lane] = c0; cumL[2 * lane + 1] = c1; dtL[2 * lane] = dt0; dtL[2 * lane + 1] = dt1;
            wgL[2 * lane] = dt0 * __expf(clast - c0); wgL[2 * lane + 1] = dt1 * __expf(clast - c1);
        }
        u32x2 zr[4];
        { const int tl = (t0 + lrow) < L ? (t0 + lrow) : (L - 1);
#pragma unroll
          for (int q = 0; q < 4; ++q) zr[q] = *(const u32x2*)(Z + (size_t)(row0 + tl) * 2048 + h * 64 + pt * 32 + 8 * q + 4 * hh); }
        const bool last_chunk = (c + 1 == nch); const int nitem = item + (int)gridDim.x; const bool has_next_item = nitem < NITEMS;
        const int cur_row0 = row0, cur_L = L, cur_h = h, cur_isP = isP; const float cur_dsk = dsk; const size_t cur_sbase = sbase;
        __builtin_amdgcn_sched_barrier(0);
        if (last_chunk && has_next_item) SSD_DECODE(nitem);
        SSD_LOAD(row0, L, h, g, last_chunk ? 0 : c + 1);
        SSD_LOAD_S0((last_chunk && has_next_item && !isP) ? p.in[4] + sbase : zpage);
        SSD_BAR();
        const bool act = lt * 32 < nv;
        f32x16 accY;
#pragma unroll
        for (int r = 0; r < 16; ++r) accY[r] = 0.f;
        float cl = 0.f;
        if (act) {
#pragma unroll
            for (int ks = 0; ks < 8; ++ks) { const pg8::bf16x8 Sf = RROW(SI_S, pt, ks), Cf = RROW(SI_C, lt, ks); accY = __builtin_amdgcn_mfma_f32_32x32x16_bf16(Sf, Cf, accY, 0, 0, 0); }
            cl = cumL[lrow]; const float el = __expf(cl);
#pragma unroll
            for (int r = 0; r < 16; ++r) accY[r] *= el;
#pragma unroll
            for (int si = 0; si < 2; ++si) {
                const int st = 2 * pt + si;
                if (st <= lt && st * 32 < nv) {
                    f32x16 accG;
#pragma unroll
                    for (int r = 0; r < 16; ++r) accG[r] = 0.f;
#pragma unroll
                    for (int ks = 0; ks < 8; ++ks) { const pg8::bf16x8 Bf = RROW(SI_B, st, ks), Cf = RROW(SI_C, lt, ks); accG = __builtin_amdgcn_mfma_f32_32x32x16_bf16(Bf, Cf, accG, 0, 0, 0); }
#pragma unroll
                    for (int q = 0; q < 4; ++q) {
                        const int s4 = st * 32 + 8 * q + 4 * hh; const f4 cs = *(const LAS f4*)(cumL + s4), ds = *(const LAS f4*)(dtL + s4); float mv[4];
#pragma unroll
                        for (int e = 0; e < 4; ++e) mv[e] = (s4 + e <= lrow) ? accG[4 * q + e] * __expf(cl - cs[e]) * ds[e] : 0.f;
                        u32x2 wv; wv.x = pg8::cvt_pk_bf16(mv[0], mv[1]); wv.y = pg8::cvt_pk_bf16(mv[2], mv[3]);
                        *(LAS u32x2*)(lds + SI_M + (mW ^ (64u * st + 16u * q))) = wv;
                    }
                }
            }
        }
        SSD_BAR();
        if (act) {
            const int kl = 2 * (lt + 1) < ksmax ? 2 * (lt + 1) : ksmax;
#define SSD_C2(NK) do { _Pragma("unroll") for (int ks = 0; ks < (NK); ++ks) { const pg8::bf16x8 Xf = RTR(SI_X, trX0, trX1, ks); const pg8::bf16x8 Mf = RROW(SI_M, lt, ks); accY = __builtin_amdgcn_mfma_f32_32x32x16_bf16(Xf, Mf, accY, 0, 0, 0); } } while (0)
            if (nv == 128) { if (lt == 0) SSD_C2(2); else if (lt == 1) SSD_C2(4); else if (lt == 2) SSD_C2(6); else SSD_C2(8); }
            else for (int ks = 0; ks < kl; ++ks) { const pg8::bf16x8 Xf = RTR(SI_X, trX0, trX1, ks); const pg8::bf16x8 Mf = RROW(SI_M, lt, ks); accY = __builtin_amdgcn_mfma_f32_32x32x16_bf16(Xf, Mf, accY, 0, 0, 0); }
#undef SSD_C2
            if (t0 + lrow < cur_L) {
#pragma unroll
                for (int q = 0; q < 4; ++q) {
                    const unsigned p4 = pt * 32 + 8 * q + 4 * hh; const u32x2 xr = *(const LAS u32x2*)(lds + SI_X + (mW ^ (64u * pt + 16u * q)));
                    const float x0 = __uint_as_float(xr.x << 16), x1 = __uint_as_float(xr.x & 0xffff0000u), x2 = __uint_as_float(xr.y << 16), x3 = __uint_as_float(xr.y & 0xffff0000u);
                    const float z0 = __uint_as_float(zr[q].x << 16), z1 = __uint_as_float(zr[q].x & 0xffff0000u), z2 = __uint_as_float(zr[q].y << 16), z3 = __uint_as_float(zr[q].y & 0xffff0000u);
                    u32x2 wv; wv.x = pg8::cvt_pk_bf16((accY[4 * q] + cur_dsk * x0) * silu_f(z0), (accY[4 * q + 1] + cur_dsk * x1) * silu_f(z1));
                    wv.y = pg8::cvt_pk_bf16((accY[4 * q + 2] + cur_dsk * x2) * silu_f(z2), (accY[4 * q + 3] + cur_dsk * x3) * silu_f(z3));
                    *(u32x2*)(Y + (size_t)(cur_row0 + t0 + lrow) * 2048 + cur_h * 64 + p4) = wv;
                }
            }
        }
        {
            const float el = __expf(cumL[127]);
#pragma unroll
            for (int r = 0; r < 16; ++r) accS[r] *= el;
#define SSD_D_STEP(ks) do { \
                const pg8::bf16x8 Bf = RTR(SI_B, trB0, trB1, ks); const pg8::bf16x8 Xr = RTR(SI_X, trX0, trX1, ks); \
                const f4 w0 = *(const LAS f4*)(wgL + 16 * (ks) + 8 * hh), w1 = *(const LAS f4*)(wgL + 16 * (ks) + 8 * hh + 4); \
                float xf[8]; \
                _Pragma("unroll") for (int j = 0; j < 8; ++j) xf[j] = __uint_as_float(((unsigned)(unsigned short)Xr[j]) << 16); \
                pg8::u32x4 pk; pk.x = pg8::cvt_pk_bf16(xf[0] * w0.x, xf[1] * w0.y); pk.y = pg8::cvt_pk_bf16(xf[2] * w0.z, xf[3] * w0.w); pk.z = pg8::cvt_pk_bf16(xf[4] * w1.x, xf[5] * w1.y); pk.w = pg8::cvt_pk_bf16(xf[6] * w1.z, xf[7] * w1.w); \
                pg8::bf16x8 Xw; __builtin_memcpy(&Xw, &pk, 16); \
                accS = __builtin_amdgcn_mfma_f32_32x32x16_bf16(Bf, Xw, accS, 0, 0, 0); } while (0)
            if (ksmax == 8) {
#pragma unroll
                for (int ks = 0; ks < 8; ++ks) SSD_D_STEP(ks);
            } else for (int ks = 0; ks < ksmax; ++ks) SSD_D_STEP(ks);
#undef SSD_D_STEP
        }
        SSD_BAR();
        if (!last_chunk) { SSD_WRITE_S(); ++c; }
        else {
            float* so = p.out + (cur_isP ? O4 : O8) + cur_sbase;
#pragma unroll
            for (int q = 0; q < 4; ++q) *(f4*)(so + 8 * q) = (f4){accS[4 * q], accS[4 * q + 1], accS[4 * q + 2], accS[4 * q + 3]};
            if (!has_next_item) break;
            item = nitem; c = 0;
        }
    }
    asm volatile("s_waitcnt vmcnt(0)" ::: "memory");
    __syncthreads();
#undef SSD_LOAD
#undef RROW
#undef RTR
#undef SSD_LOAD_S0
#undef SSD_DECODE
#undef SSD_WRITE_S
}
__device__ __forceinline__ void phase_gnorm(const Params& p) {
    bf16_t* Y = (bf16_t*)(p.ws + W_BIG) + (size_t)MP * 2048; const float* nw = p.in[19];
    const int lane = threadIdx.x & 63, wv = threadIdx.x >> 6; constexpr int NR = 3; const int rstride = gridDim.x * 8;
    float w[4][8];
#pragma unroll
    for (int i = 0; i < 4; ++i) load8f(nw + lane * 32 + i * 8, w[i]);
    for (int row0 = blockIdx.x * 8 + wv; row0 < T; row0 += NR * rstride) {
        uint4 raw[NR][4];
#pragma unroll
        for (int u = 0; u < NR; ++u) { const int row = row0 + u * rstride < T ? row0 + u * rstride : row0;
#pragma unroll
            for (int i = 0; i < 4; ++i) raw[u][i] = *(const uint4*)(Y + (size_t)row * 2048 + lane * 32 + i * 8); }
#pragma unroll
        for (int u = 0; u < NR; ++u) { const int row = row0 + u * rstride; float v[4][8]; float s = 0.f;
#pragma unroll
            for (int i = 0; i < 4; ++i) { unpack8(raw[u][i], v[i]);
#pragma unroll
                for (int j = 0; j < 8; ++j) s += v[i][j] * v[i][j]; }
            s += __shfl_xor(s, 1); s += __shfl_xor(s, 2); s += __shfl_xor(s, 4); s += __shfl_xor(s, 8);
            const float rs = __builtin_amdgcn_rsqf(s * (1.0f / 512.0f) + EPS);
            if (row < T) {
#pragma unroll
                for (int i = 0; i < 4; ++i) {
#pragma unroll
                    for (int j = 0; j < 8; ++j) v[i][j] *= rs * w[i][j];
                    *(uint4*)(Y + (size_t)row * 2048 + lane * 32 + i * 8) = pack8(v[i]); } }
        }
    }
}
__device__ __forceinline__ void phase_final(const Params& p) {
    const bf16_t* Xb = (const bf16_t*)(p.ws + W_XB); const float* SS4 = (const float*)(p.ws + W_SS) + 4 * (size_t)MP; const float* nw = p.in[9];
    const int lane = threadIdx.x & 63, wv = threadIdx.x >> 6; constexpr int NR = 3; const int rstride = gridDim.x * 8;
    float w[2][8];
#pragma unroll
    for (int i = 0; i < 2; ++i) load8f(nw + i * 512 + lane * 8, w[i]);
    for (int row0 = blockIdx.x * 8 + wv; row0 < T; row0 += NR * rstride) {
        uint4 raw[NR][2]; float ssv[NR];
#pragma unroll
        for (int u = 0; u < NR; ++u) { const int row = row0 + u * rstride < T ? row0 + u * rstride : row0; ssv[u] = SS4[row];
#pragma unroll
            for (int i = 0; i < 2; ++i) raw[u][i] = *(const uint4*)(Xb + (size_t)row * 1024 + i * 512 + lane * 8); }
#pragma unroll
        for (int u = 0; u < NR; ++u) { const int row = row0 + u * rstride;
            if (row >= T) continue;
            int isP, b, t; row_decode(row, isP, b, t);
            if (isP && t < NMETA) continue;
            float* o = isP ? p.out + O0 + ((size_t)b * 2048 + (t - NMETA)) * 1024 : p.out + O1 + (size_t)(row - T_P) * 1024;
            const float rs = __builtin_amdgcn_rsqf(ssv[u] * (1.0f / 1024.0f) + EPS);
#pragma unroll
            for (int i = 0; i < 2; ++i) { float v[8]; unpack8(raw[u][i], v);
#pragma unroll
                for (int j = 0; j < 8; ++j) v[j] *= rs * w[i][j];
                store8f(o + i * 512 + lane * 8, v); }
        }
    }
}

#define XB_TMO      128
#define XB_XCNT(j)  (256  + 64 * (j))
#define XB_XSUB(j)  (1280 + 64 * (j))
#define XB_XGEN(j)  (2304 + 64 * (j))
#define XB_TOP      3328
#define XB_TOPGEN   3392
#define XCD_BAR_WORDS 3456
#define XB_SPIN_CAP (1u << 18)
#define LAS __attribute__((address_space(3)))

__device__ __forceinline__ unsigned xb_ld(unsigned* p)              { return __hip_atomic_load(p, __ATOMIC_RELAXED, __HIP_MEMORY_SCOPE_AGENT); }
__device__ __forceinline__ unsigned xb_add(unsigned* p, unsigned v) { return __hip_atomic_fetch_add(p, v, __ATOMIC_RELAXED, __HIP_MEMORY_SCOPE_AGENT); }
__device__ __forceinline__ unsigned xb_xcc_id() { return (unsigned)__builtin_amdgcn_s_getreg((3 << 11) | 20) & 0xFu; }
#define XB_SPIN(cond, bar) do { unsigned _sp = 0; while (cond) { __builtin_amdgcn_s_sleep(1); \
    if ((++_sp & 255u) == 0u) { if (xb_ld(&(bar)[XB_TMO])) break; if (_sp > XB_SPIN_CAP) { atomicAdd(&(bar)[XB_TMO], 1u); break; } } } } while (0)

struct XcdBarrier {
    unsigned* bar; unsigned x;
    volatile LAS unsigned* st;
};

__device__ __forceinline__ XcdBarrier xcd_barrier_post(unsigned* bar, volatile LAS unsigned* st) {
    XcdBarrier b; b.bar = bar; b.x = xb_xcc_id(); b.st = st;
    if (threadIdx.x == 0) (void)xb_add(&bar[XB_XCNT(b.x)], 1u);
    return b;
}
__device__ __forceinline__ void xcd_barrier_complete(unsigned* bar, unsigned x, unsigned& nloc, unsigned& nx) {
    const unsigned G = gridDim.x * gridDim.y * gridDim.z;
    unsigned sum, cnt, mine, sp = 0u;
    for (;;) {
        sum = 0u; cnt = 0u; mine = 0u;
#pragma unroll
        for (unsigned j = 0; j < 16; ++j) { const unsigned c = xb_ld(&bar[XB_XCNT(j)]); sum += c; cnt += (c > 0u) ? 1u : 0u; mine = (j == x) ? c : mine; }
        if (sum == G) break;
        __builtin_amdgcn_s_sleep(1);
        if ((++sp & 255u) == 0u) { if (xb_ld(&bar[XB_TMO])) break; if (sp > XB_SPIN_CAP) { atomicAdd(&bar[XB_TMO], 1u); break; } }
    }
    nloc = mine > 0u ? mine : 1u; nx = cnt > 0u ? cnt : 1u;
}

__device__ __forceinline__ void xcd_barrier(const XcdBarrier& b) {
    asm volatile("s_waitcnt vmcnt(0)" ::: "memory");
    __syncthreads();
    if (threadIdx.x == 0) {
        unsigned* bar = b.bar;
        __builtin_amdgcn_s_waitcnt(0);
        unsigned nloc = b.st[0], nx = b.st[1];
        if (nloc == 0u) { xcd_barrier_complete(bar, b.x, nloc, nx); b.st[0] = nloc; b.st[1] = nx; }
        const unsigned old = xb_add(&bar[XB_XSUB(b.x)], 1u);
        const unsigned gen = old / nloc;
        if (old + 1u == (gen + 1u) * nloc) {
            __builtin_amdgcn_fence(__ATOMIC_RELEASE, "agent");
            asm volatile("s_waitcnt vmcnt(0)" ::: "memory");
            const unsigned og = xb_add(&bar[XB_TOP], 1u);
            const unsigned tg = og / nx;
            if (og + 1u == (tg + 1u) * nx) xb_add(&bar[XB_TOPGEN], 1u);
            else XB_SPIN(xb_ld(&bar[XB_TOPGEN]) == tg, bar);
            __builtin_amdgcn_fence(__ATOMIC_ACQUIRE, "agent");
            xb_add(&bar[XB_XGEN(b.x)], 1u);
            asm volatile("s_waitcnt vmcnt(0)" ::: "memory");
        } else {
            XB_SPIN(xb_ld(&bar[XB_XGEN(b.x)]) == gen, bar);
            __builtin_amdgcn_fence(__ATOMIC_ACQUIRE, "agent");
            asm volatile("s_waitcnt vmcnt(0)" ::: "memory");
        }
    }
    __syncthreads();
}


constexpr int NPHASE = 16, LDS_BYTES = SSD_LDS + 16;
__global__ void __launch_bounds__(512) fwd_megakernel(Params p) {
    extern __shared__ __attribute__((aligned(16))) unsigned char shm[];
    cg::grid_group grid = cg::this_grid();
    unsigned char* ws = p.ws;
    volatile LAS unsigned* xst = (volatile LAS unsigned*)((LAS unsigned char*)shm + (LDS_BYTES - 16));
    if (threadIdx.x == 0) { xst[0] = 0u; xst[1] = 0u; }
    __syncthreads();
    const XcdBarrier xb = xcd_barrier_post((unsigned*)(ws + W_BAR), xst);
    if (p.ph_hi > NPHASE) grid.sync();
    bf16_t* XB = (bf16_t*)(ws + W_XB); bf16_t* BIG = (bf16_t*)(ws + W_BIG); bf16_t* ABUF = (bf16_t*)(ws + W_ABUF); float* SS = (float*)(ws + W_SS);
#define PHASE(n, ...) if (p.ph_lo <= (n) && (n) < p.ph_hi) { __VA_ARGS__; if ((n) + 1 < p.ph_hi) xcd_barrier(xb); }
#define GEMM_S(n, WOFF, NN, LD0, NC0, O1P, LD1, NC1, SSI, ...) PHASE(n, { EpiScale E; E.O0 = BIG; E.ld0 = LD0; E.ncol0 = NC0; E.O1 = O1P; E.ld1 = LD1; E.ncol1 = NC1; E.DT = (float*)(ws + W_DTRAW); E.ss = SS + (size_t)(SSI) * MP; \
        run_gemm((PG8_LAS unsigned char*)shm, XB, (const bf16_t*)(ws + WOFF), NN, 1024, E); __VA_ARGS__; })
#define GEMM_R(n, AP, WOFF, KK, SSI, ...) PHASE(n, { EpiResid E; E.Xb = XB; E.ssn = SS + (size_t)(SSI) * MP; \
        run_gemm_s<EpiResid, pg8::TailOrder>((PG8_LAS unsigned char*)shm, AP, (const bf16_t*)(ws + WOFF), 1024, KK, E); __VA_ARGS__; })
    PHASE(0, phase_prep(p, (float*)shm))
    GEMM_S(1, W_SC_IN, 3072, 3072, 3072, BIG, 0, 0, 0, if (blockIdx.x >= 60 && gridDim.x > 60) convert_tiles(p, (float*)shm, 192, 608, (int)blockIdx.x - 60, (int)gridDim.x - 60))
    PHASE(2, phase_sc_conv(p))
    GEMM_R(3, ABUF, W_SC_OUT, 1024, 1, if (blockIdx.x >= 80 && gridDim.x > 80) convert_tiles(p, (float*)shm, 608, 784, (int)blockIdx.x - 80, (int)gridDim.x - 80))
    PHASE(4, { { const float* cwg_ = p.in[23]; PG8_LAS unsigned* dst_ = (PG8_LAS unsigned*)((PG8_LAS unsigned char*)shm + 131072); for (int q_ = threadIdx.x; q_ < 3 * DFF / 2; q_ += 512) dst_[q_] = pg8::cvt_pk_bf16(cwg_[2 * q_], cwg_[2 * q_ + 1]); __syncthreads(); }
        EpiFfn E; E.U = BIG; E.A2 = ABUF; E.ss = SS + (size_t)1 * MP; E.cwl = (PG8_LAS const unsigned char*)shm + 131072; run_gemm((PG8_LAS unsigned char*)shm, XB, (const bf16_t*)(ws + W_UG0), NUG, 1024, E); })
    PHASE(5, phase_ffn_fix(p, 0))
    GEMM_R(6, ABUF, W_DN0, DFF, 2, if (blockIdx.x >= 80 && gridDim.x > 80) convert_tiles(p, (float*)shm, 784, 1248, (int)blockIdx.x - 80, (int)gridDim.x - 80))
    PHASE(7, { EpiSsm E; E.Zo = BIG; E.RAW = BIG + (size_t)MP * 2048; E.XC = ABUF; E.DTS = (float*)(ws + W_DTS); E.ss = SS + (size_t)2 * MP; E.cw = p.in[14]; E.cb = p.in[15]; E.dtb = p.in[16]; run_gemm((PG8_LAS unsigned char*)shm, XB, (const bf16_t*)(ws + W_SSM_IN), NINP, 1024, E); })
    PHASE(8, phase_ssm_fix(p))
    PHASE(9, phase_ssd(p, (LAS unsigned char*)shm))
    PHASE(10, phase_gnorm(p))
    GEMM_R(11, BIG + (size_t)MP * 2048, W_SSM_OUT, 2048, 3, if (blockIdx.x >= 80 && gridDim.x > 80) convert_tiles(p, (float*)shm, 1248, 1776, (int)blockIdx.x - 80, (int)gridDim.x - 80))
    PHASE(12, { { const float* cwg_ = p.in[23] + (size_t)3 * DFF; PG8_LAS unsigned* dst_ = (PG8_LAS unsigned*)((PG8_LAS unsigned char*)shm + 131072); for (int q_ = threadIdx.x; q_ < 3 * DFF / 2; q_ += 512) dst_[q_] = pg8::cvt_pk_bf16(cwg_[2 * q_], cwg_[2 * q_ + 1]); __syncthreads(); }
        EpiFfn E; E.U = BIG; E.A2 = ABUF; E.ss = SS + (size_t)3 * MP; E.cwl = (PG8_LAS const unsigned char*)shm + 131072; run_gemm((PG8_LAS unsigned char*)shm, XB, (const bf16_t*)(ws + W_UG1), NUG, 1024, E); })
    PHASE(13, phase_ffn_fix(p, 1))
    GEMM_R(14, ABUF, W_DN1, DFF, 4)
    PHASE(15, phase_final(p))
}

extern "C" void kernel_launch(void* const* d_in, const int* in_sizes, int n_in, void* d_out, int out_size, void* d_ws, size_t ws_size, hipStream_t stream) {
    static int grid_blocks = 0;
    if (grid_blocks == 0) {
        if (n_in != 25 || (size_t)out_size != OEND || ws_size < W_END) { fprintf(stderr, "kernel_launch: unexpected shapes: n_in %d out %d ws %zu (need %zu)\n", n_in, out_size, ws_size, (size_t)W_END); grid_blocks = -1; return; }
        int dev = 0, cus = 0, per_cu = 0;
        hipGetDevice(&dev); hipDeviceGetAttribute(&cus, hipDeviceAttributeMultiprocessorCount, dev);
        if (hipFuncSetAttribute((const void*)fwd_megakernel, hipFuncAttributeMaxDynamicSharedMemorySize, LDS_BYTES) != hipSuccess) { fprintf(stderr, "kernel_launch: hipFuncSetAttribute failed\n"); grid_blocks = -1; return; }
        if (hipOccupancyMaxActiveBlocksPerMultiprocessor(&per_cu, (const void*)fwd_megakernel, 512, LDS_BYTES) != hipSuccess || per_cu < 1) { fprintf(stderr, "kernel_launch: occupancy query gave %d\n", per_cu); per_cu = 1; }
        (void)hipGetLastError();
        grid_blocks = cus * 1;
    }
    if (grid_blocks < 0) return;
    if (hipMemsetAsync((unsigned char*)d_ws + W_BAR, 0, 16384, stream) != hipSuccess) { fprintf(stderr, "kernel_launch: memset of barrier words failed\n"); return; }
    Params p{};
    for (int i = 0; i < 25; ++i) p.in[i] = (const float*)d_in[i];
    p.out = (float*)d_out; p.ws = (unsigned char*)d_ws;
#ifdef MULTI_LAUNCH
    for (int ph = 0; ph < NPHASE; ++ph) { p.ph_lo = ph; p.ph_hi = ph + 1; hipLaunchKernelGGL(fwd_megakernel, dim3(grid_blocks), dim3(512), LDS_BYTES, stream, p); }
#else
    p.ph_lo = 0; p.ph_hi = NPHASE;
    void* args[] = {&p};
    hipError_t e = hipLaunchCooperativeKernel((const void*)fwd_megakernel, dim3(grid_blocks), dim3(512), args, LDS_BYTES, stream);
    if (e != hipSuccess) fprintf(stderr, "cooperative launch failed: %s (grid %d)\n", hipGetErrorString(e), grid_blocks);
#endif
}
```
